# Optimizing an MI355X kernel written in HIP

```python
import jax, jax.numpy as jnp
from jax import lax
import numpy as np

D_MODEL = 1024
BATCH = 4
SEQ = 8192
DEPTH = 2

D_INNER = 2 * D_MODEL
D_MLSTM = D_INNER // 2
D_RET = D_INNER - D_MLSTM
N_HEADS_MLSTM = 4
N_HEADS_RET = 4
HD_M = D_MLSTM // N_HEADS_MLSTM
HD_R = D_RET // N_HEADS_RET
CONV_K = 4
CHUNK = 64
EPS = 1e-6
ROPE_BASE = 10000.0
D_IN_PROJ = 5 * D_MLSTM + 2 * N_HEADS_MLSTM + 4 * D_RET

kernel_name = 'hybrid_mlstm_retention_parallel_heads'


def rmsnorm(x, g):
    xf = x.astype(jnp.float32)
    y = xf * lax.rsqrt(jnp.mean(xf * xf, axis=-1, keepdims=True) + EPS)
    return (y * g.astype(jnp.float32)).astype(x.dtype)


def head_layernorm(h, g, n_heads):
    B, S, W = h.shape
    hf = h.astype(jnp.float32).reshape(B, S, n_heads, W // n_heads)
    mu = jnp.mean(hf, axis=-1, keepdims=True)
    var = jnp.mean(jnp.square(hf - mu), axis=-1, keepdims=True)
    y = ((hf - mu) * lax.rsqrt(var + EPS)).reshape(B, S, W)
    return (y * g.astype(jnp.float32)).astype(h.dtype)


def causal_dwconv(x, w, b):
    S = x.shape[1]
    xp = jnp.pad(x, ((0, 0), (CONV_K - 1, 0), (0, 0)))
    y = xp[:, 0:S] * w[0]
    for t in range(1, CONV_K):
        y = y + xp[:, t:t + S] * w[t]
    return y + b


def split_cols(p):
    sizes = [D_MLSTM] * 5 + [N_HEADS_MLSTM] * 2 + [D_RET] * 4
    idx = np.cumsum(sizes)[:-1].tolist()
    return jnp.split(p, idx, axis=-1)


def to_chunks(t):
    B, S, H, d = t.shape
    return t.reshape(B, S // CHUNK, CHUNK, H, d).transpose(1, 0, 3, 2, 4)


def from_chunks(t):
    NC, B, H, L, d = t.shape
    return t.transpose(1, 0, 3, 2, 4).reshape(B, NC * L, H * d)


def gate_chunks(t):
    B, S, H = t.shape
    return t.reshape(B, S // CHUNK, CHUNK, H).transpose(1, 0, 3, 2)


def rotary(t, positions):
    d = t.shape[-1]
    inv_freq = 1.0 / (ROPE_BASE ** jnp.linspace(0.0, 1.0, d // 2, dtype=jnp.float32))
    ang = positions.astype(jnp.float32)[..., None] * inv_freq
    cos = jnp.cos(ang)[:, :, None, :].astype(t.dtype)
    sin = jnp.sin(ang)[:, :, None, :].astype(t.dtype)
    t1, t2 = jnp.split(t, 2, axis=-1)
    return jnp.concatenate([t1 * cos - t2 * sin, t2 * cos + t1 * sin], axis=-1)


def mlstm_chunkwise(q, k, v, i_pre, f_pre):
    B, S, H, d = q.shape
    k = k * (d ** -0.5)
    li = gate_chunks(i_pre.astype(jnp.float32))
    lf = gate_chunks(jax.nn.log_sigmoid(f_pre.astype(jnp.float32)))
    causal = jnp.tril(jnp.ones((CHUNK, CHUNK), dtype=bool))

    def step(carry, inp):
        C, n, m = carry
        qj, kj, vj, lij, lfj = inp
        b = jnp.cumsum(lfj, axis=-1)
        a = b + m[..., None]
        g = b[..., :, None] - b[..., None, :] + lij[..., None, :]
        g = jnp.where(causal, g, -jnp.inf)
        m_row = jnp.maximum(a, jnp.max(g, axis=-1))
        w_intra = jnp.exp(g - m_row[..., None])
        w_inter = jnp.exp(a - m_row)
        s = jnp.einsum('bhld,bhsd->bhls', qj, kj) * w_intra
        num = (jnp.einsum('bhls,bhsv->bhlv', s, vj)
               + w_inter[..., None] * jnp.einsum('bhvk,bhlk->bhlv', C, qj))
        den = jnp.sum(s, axis=-1) + w_inter * jnp.einsum('bhk,bhlk->bhl', n, qj)
        h = num / jnp.maximum(jnp.abs(den), jnp.exp(-m_row))[..., None]
        bL = b[..., -1]
        g_end = bL[..., None] - b + lij
        m_new = jnp.maximum(bL + m, jnp.max(g_end, axis=-1))
        w_end = jnp.exp(g_end - m_new[..., None])
        decay = jnp.exp(bL + m - m_new)
        C_new = decay[..., None, None] * C + jnp.einsum('bhs,bhsv,bhsk->bhvk', w_end, vj, kj)
        n_new = decay[..., None] * n + jnp.einsum('bhs,bhsk->bhk', w_end, kj)
        return (C_new, n_new, m_new), h.astype(q.dtype)

    init = (jnp.zeros((B, H, d, d), jnp.float32),
            jnp.zeros((B, H, d), jnp.float32),
            jnp.zeros((B, H), jnp.float32))
    _, hs = lax.scan(step, init, (to_chunks(q), to_chunks(k), to_chunks(v), li, lf))
    return from_chunks(hs)


def retention_chunkwise(q, k, v):
    B, S, H, d = q.shape
    k = k * (d ** -0.5)
    log_gamma = jnp.log(1.0 - 2.0 ** (-5.0 - jnp.arange(H, dtype=jnp.float32)))
    pos = jnp.arange(CHUNK, dtype=jnp.float32)
    diff = pos[:, None] - pos[None, :]
    Dmat = jnp.where(diff >= 0, jnp.exp(log_gamma[:, None, None] * jnp.maximum(diff, 0.0)), 0.0)
    xi = jnp.exp(log_gamma[:, None] * (pos + 1.0))
    zeta = jnp.exp(log_gamma[:, None] * (CHUNK - 1.0 - pos))
    g_chunk = jnp.exp(log_gamma * CHUNK)

    def step(R, inp):
        qj, kj, vj = inp
        s = jnp.einsum('bhld,bhsd->bhls', qj, kj) * Dmat
        o = (jnp.einsum('bhls,bhsv->bhlv', s, vj)
             + xi[..., None] * jnp.einsum('bhlk,bhkv->bhlv', qj, R))
        R_new = g_chunk[:, None, None] * R + jnp.einsum('bhsk,bhsv->bhkv', kj * zeta[..., None], vj)
        return R_new, o.astype(q.dtype)

    init = jnp.zeros((B, H, d, d), jnp.float32)
    _, os_ = lax.scan(step, init, (to_chunks(q), to_chunks(k), to_chunks(v)))
    return from_chunks(os_)


def setup_inputs(seed: int = 0) -> dict:
    key = jax.random.key(seed)
    ks = jax.random.split(key, 16)
    f32 = jnp.float32
    x = jax.random.normal(ks[0], (BATCH, SEQ, D_MODEL), f32)
    c = jax.random.normal(ks[1], (BATCH, D_MODEL), f32)
    offset = jax.random.randint(ks[2], (BATCH, 1), 0, 4096, dtype=jnp.int32)
    positions = offset + jnp.arange(SEQ, dtype=jnp.int32)[None, :]
    w_ada = jax.random.normal(ks[3], (DEPTH, D_MODEL, 3 * D_MODEL), f32) * (0.5 * D_MODEL ** -0.5)
    b_ada = jax.random.normal(ks[4], (DEPTH, 3 * D_MODEL), f32) * 0.02
    norm_g = 1.0 + 0.02 * jax.random.normal(ks[5], (DEPTH, D_MODEL), f32)
    w_in = jax.random.normal(ks[6], (DEPTH, D_MODEL, D_IN_PROJ), f32) * (D_MODEL ** -0.5)
    conv_w = jax.random.normal(ks[7], (DEPTH, CONV_K, 2 * D_MLSTM), f32) * (CONV_K ** -0.5)
    conv_b = jax.random.normal(ks[8], (DEPTH, 2 * D_MLSTM), f32) * 0.02
    b_igate = jax.random.normal(ks[9], (DEPTH, N_HEADS_MLSTM), f32) * 0.1
    b_fgate = (jnp.linspace(3.0, 6.0, N_HEADS_MLSTM, dtype=f32)[None, :]
               + 0.1 * jax.random.normal(ks[10], (DEPTH, N_HEADS_MLSTM), f32))
    gn_m = 1.0 + 0.02 * jax.random.normal(ks[11], (DEPTH, D_MLSTM), f32)
    gn_r = 1.0 + 0.02 * jax.random.normal(ks[12], (DEPTH, D_RET), f32)
    w_out = jax.random.normal(ks[13], (DEPTH, D_INNER, D_MODEL), f32) * (D_INNER ** -0.5)
    final_g = 1.0 + 0.02 * jax.random.normal(ks[14], (D_MODEL,), f32)
    return {'x': x, 'c': c, 'positions': positions, 'w_ada': w_ada, 'b_ada': b_ada,
            'norm_g': norm_g, 'w_in': w_in, 'conv_w': conv_w, 'conv_b': conv_b,
            'b_igate': b_igate, 'b_fgate': b_fgate, 'gn_m': gn_m, 'gn_r': gn_r,
            'w_out': w_out, 'final_g': final_g}


def reference(x, c, positions, w_ada, b_ada, norm_g, w_in, conv_w, conv_b,
              b_igate, b_fgate, gn_m, gn_r, w_out, final_g):
    B, S, _ = x.shape
    c_act = jax.nn.silu(c)
    for l in range(DEPTH):
        ada = c_act @ w_ada[l] + b_ada[l]
        shift, scale, gate = jnp.split(ada, 3, axis=-1)
        h = rmsnorm(x, norm_g[l]) * (1.0 + scale[:, None, :]) + shift[:, None, :]
        p = h @ w_in[l]
        mq, mk, mv, mo, mz, mi, mf, rq, rk, rv, rz = split_cols(p)

        qk = jax.nn.silu(causal_dwconv(jnp.concatenate([mq, mk], axis=-1), conv_w[l], conv_b[l]))
        mq_c, mk_c = jnp.split(qk, 2, axis=-1)
        cell = mlstm_chunkwise(mq_c.reshape(B, S, N_HEADS_MLSTM, HD_M),
                               mk_c.reshape(B, S, N_HEADS_MLSTM, HD_M),
                               mv.reshape(B, S, N_HEADS_MLSTM, HD_M),
                               mi + b_igate[l], mf + b_fgate[l])
        y_m = jax.nn.sigmoid(mo) * head_layernorm(cell, gn_m[l], N_HEADS_MLSTM) * jax.nn.silu(mz)

        rq_h = rotary(rq.reshape(B, S, N_HEADS_RET, HD_R), positions)
        rk_h = rotary(rk.reshape(B, S, N_HEADS_RET, HD_R), positions)
        ret = retention_chunkwise(rq_h, rk_h, rv.reshape(B, S, N_HEADS_RET, HD_R))
        y_r = head_layernorm(ret, gn_r[l], N_HEADS_RET) * jax.nn.silu(rz)

        y = jnp.concatenate([y_m, y_r], axis=-1) @ w_out[l]
        x = x + gate[:, None, :] * y
    return rmsnorm(x, final_g)
```

```cpp
#include <hip/hip_runtime.h>
#include <hip/hip_cooperative_groups.h>
#include <cstdint>
#include <cstdio>
namespace cg = cooperative_groups;

#define LAS __attribute__((address_space(3)))
#define DI __device__ __forceinline__
typedef unsigned short bf16_t;
typedef short bf16x8 __attribute__((ext_vector_type(8)));
typedef short s16x4 __attribute__((ext_vector_type(4)));
typedef float f32x4 __attribute__((ext_vector_type(4)));
typedef unsigned u32x4 __attribute__((ext_vector_type(4)));
typedef unsigned u32x2 __attribute__((ext_vector_type(2)));

constexpr int NB = 4, S = 8192, D = 1024, M = NB * S;
constexpr int NPC = 9216;
constexpr int NSRC = 9224;
constexpr int NSEG = 2, SEG = S / NSEG, MSEG = NB * SEG, TPB = SEG / 256, NCH = SEG / 64;
constexpr int NT = 512;
constexpr float EPS = 1e-6f;

constexpr size_t MiB = 1u << 20;
constexpr size_t WS_ADA = 1 * MiB;
constexpr size_t WS_INVF = WS_ADA + 128 * 1024;
constexpr size_t WS_WG = 1 * MiB + 512 * 1024;
constexpr size_t WS_HALO = WS_INVF + 4096;
constexpr size_t WS_MSAVE = WS_HALO + 128 * 1024;
constexpr size_t WS_GATES = 2 * MiB;
constexpr size_t WS_GTAB = 3 * MiB;
constexpr size_t WS_T2 = 4 * MiB + 512 * 1024;
constexpr size_t WS_T2RAW = 4 * MiB + 768 * 1024;
constexpr size_t WS_DN = 5 * MiB;
constexpr size_t WS_DN2 = 5 * MiB + 512 * 1024;
constexpr size_t WS_WIN = 16 * MiB;
constexpr size_t WS_WOUT = 52 * MiB;
constexpr size_t WS_H = 64 * MiB;
constexpr size_t WS_QK = 128 * MiB;
constexpr size_t WS_P = 192 * MiB;
constexpr size_t WS_CSAVE = 480 * MiB;
constexpr size_t WS_XCH = 6 * MiB;
constexpr size_t WS_XCNT = 16384;
constexpr size_t WS_END = 512 * MiB;

constexpr int LDS_BYTES = 147456;

struct Params {
    const float* x; const float* c; const int* pos; const float* w_ada; const float* b_ada; const float* norm_g;
    const float* w_in; const float* conv_w; const float* conv_b; const float* b_ig; const float* b_fg;
    const float* gn_m; const float* gn_r; const float* w_out; const float* final_g;
    float* out; unsigned char* ws;
    int ph_lo, ph_hi;
};

typedef __bf16 bf16v2_t __attribute__((ext_vector_type(2)));
DI unsigned cvt_pk_bf16(float lo, float hi) { bf16v2_t v; v[0] = (__bf16)lo; v[1] = (__bf16)hi; return __builtin_bit_cast(unsigned, v); }
DI float bflo(unsigned u) { return __builtin_bit_cast(float, u << 16); }
DI float bfhi(unsigned u) { return __builtin_bit_cast(float, u & 0xffff0000u); }
DI float wave_sum(float v) {
#pragma unroll
    for (int o = 1; o < 64; o <<= 1) v += __shfl_xor(v, o);
    return v;
}
DI float sigmoidf_(float x) { return 1.f / (1.f + __expf(-x)); }
DI float siluf_(float x) { return x / (1.f + __expf(-x)); }
DI int grow_of(int lrow, int seg) { return (lrow / SEG) * S + seg * SEG + (lrow % SEG); }

namespace pg8 {
constexpr int BM = 256, BK = 64, HALF = 128, HTB = HALF * BK * 2, NXCD = 8, WGM = 4;
__host__ __device__ __forceinline__ int lds_byte(int r, int c) { const int st = (r >> 4) * 2 + (c >> 5), rr = r & 15, cc = c & 31, ob = rr * 64 + cc * 2; return st * 1024 + (ob ^ (((ob >> 9) & 1) << 5)); }
__host__ __device__ __forceinline__ void stage_rc(int b, int& R, int& C) { const int st = b / 1024, sb = b % 1024, swz = sb ^ (((sb >> 9) & 1) << 5); R = (st >> 1) * 16 + swz / 64; C = (st & 1) * 32 + (swz % 64) / 2; }
__host__ __device__ __forceinline__ int perm32(int rho) { const int n = rho >> 4, i = rho & 15; return 8 * (i >> 2) + 4 * n + (i & 3); }

struct Unit { int pm, pn; };
struct Gemm { const bf16_t* A; const bf16_t* Bt; int lda, K, nM, nN, seg, amode; };

struct StaticOrder {
    int nM, nN, nwg, G, c;
    DI void init(int nM_, int nN_, int G_, int c_) { nM = nM_; nN = nN_; nwg = nM * nN; G = G_; c = c_; }
    DI bool next(int i, Unit& u) const {
        const long L = (long)i * G + c; if (L >= nwg) return false;
        int wgid = (int)L; { const int q = nwg / NXCD, r = nwg % NXCD, xcd = wgid % NXCD, off = wgid / NXCD; wgid = (xcd < r ? xcd * (q + 1) : r * (q + 1) + (xcd - r) * q) + off; }
        const int nig = WGM * nN, gid = wgid / nig, fm = gid * WGM, gsz = (nM - fm) < WGM ? (nM - fm) : WGM;
        u.pm = fm + ((wgid % nig) % gsz); u.pn = (wgid % nig) / gsz; return true;
    }
};

DI const char* a_tile(const Gemm& g, int pm) {
    const int rowbase = g.amode ? pm * BM : grow_of(pm * BM, g.seg);
    return (const char*)g.A + (size_t)rowbase * g.lda * 2;
}

template <class Epi>
DI void gemm_phase(LAS unsigned char* lds, const Gemm g, int G, int c, const Epi& E) {
    int tid = threadIdx.x; asm volatile("" : "+v"(tid));
    const int wid = __builtin_amdgcn_readfirstlane(tid >> 6), lane = tid & 63, wr = wid >> 2, wc = wid & 3, fr = lane & 15, fq = lane >> 4;
    const int K = g.K, nt = K / BK;
    unsigned voffA[2], voffB[2];
#pragma unroll
    for (int i = 0; i < 2; ++i) { int R, C; stage_rc(tid * 16 + i * 8192, R, C); const int Rb = (R & ~31) + perm32(R & 31);
        voffA[i] = (unsigned)(R * g.lda + C) * 2u; voffB[i] = (unsigned)(Rb * K + C) * 2u; }
    const size_t kstep = (size_t)(BK * 2);
    const size_t hstepA = (size_t)HALF * g.lda * 2, hstepB = (size_t)HALF * K * 2, tstepB = 2 * hstepB;
    const unsigned ldsw = (unsigned)wid * 1024u;
    const int aoff = lds_byte(wr * 64 + fr, fq * 8), boff = lds_byte(wc * 32 + fr, fq * 8);
#define PG8_SA(b, h) (((b) * 2 + (h)) * HTB)
#define PG8_SB(b, h) ((4 + (b) * 2 + (h)) * HTB)
#define PG8_STAGE(bufoff, gbase, voff) do { _Pragma("unroll") for (int _i = 0; _i < 2; ++_i) \
        __builtin_amdgcn_global_load_lds((const unsigned*)((const char*)(gbase) + (voff)[_i]), (LAS unsigned*)(lds + (bufoff) + ldsw + _i * 8192), 16, 0, 0); } while (0)
#define PG8_LDA(dst, b, h) do { _Pragma("unroll") for (int m = 0; m < 4; ++m) _Pragma("unroll") for (int k = 0; k < 2; ++k) dst[m][k] = *(const LAS bf16x8*)(lds + PG8_SA(b, h) + aoff + m * 2048 + k * 1024); } while (0)
#define PG8_LDB(dst, b, h) do { _Pragma("unroll") for (int n = 0; n < 2; ++n) _Pragma("unroll") for (int k = 0; k < 2; ++k) dst[n][k] = *(const LAS bf16x8*)(lds + PG8_SB(b, h) + boff + n * 2048 + k * 1024); } while (0)
#define PG8_MMA(ai, bj, At, Bt) do { __builtin_amdgcn_s_setprio(1); _Pragma("unroll") for (int m = 0; m < 4; ++m) _Pragma("unroll") for (int n = 0; n < 2; ++n) _Pragma("unroll") for (int k = 0; k < 2; ++k) \
        acc[ai][bj][m][n] = __builtin_amdgcn_mfma_f32_16x16x32_bf16(Bt[n][k], At[m][k], acc[ai][bj][m][n], 0, 0, 0); __builtin_amdgcn_s_setprio(0); } while (0)
#define PG8_WAIT_V(n) asm volatile("s_waitcnt vmcnt(" #n ")" ::: "memory")
#define PG8_WAIT_L(n) asm volatile("s_waitcnt lgkmcnt(" #n ")" ::: "memory")
#define PG8_BAR __builtin_amdgcn_s_barrier()
#define PG8_SCHED __builtin_amdgcn_sched_barrier(0)
    StaticOrder S; S.init(g.nM, g.nN, G, c);
    Unit cur, nxt; int ui = 0;
    if (!S.next(0, cur)) return;
    f32x4 acc[2][2][4][2];
#pragma unroll
    for (int a = 0; a < 2; ++a)
#pragma unroll
        for (int b = 0; b < 2; ++b)
#pragma unroll
            for (int m = 0; m < 4; ++m)
#pragma unroll
                for (int n = 0; n < 2; ++n) acc[a][b][m][n] = (f32x4){0.f, 0.f, 0.f, 0.f};
    bf16x8 At[4][2], B0[2][2], B1[2][2];
    const char* cA = a_tile(g, cur.pm); const char* cB = (const char*)g.Bt + (size_t)cur.pn * tstepB;
    PG8_STAGE(PG8_SB(0, 0), cB, voffB); PG8_STAGE(PG8_SB(0, 1), cB + hstepB, voffB); PG8_STAGE(PG8_SA(0, 0), cA, voffA); PG8_STAGE(PG8_SA(0, 1), cA + hstepA, voffA);
    if (wr == 1) PG8_BAR;
    PG8_WAIT_V(2); PG8_BAR;
    PG8_STAGE(PG8_SB(1, 0), cB + kstep, voffB); PG8_STAGE(PG8_SA(1, 0), cA + kstep, voffA); PG8_STAGE(PG8_SB(1, 1), cB + hstepB + kstep, voffB);
    PG8_WAIT_V(6); PG8_BAR;
    for (;;) {
        const bool has_next = S.next(ui + 1, nxt);
        const char* nA = has_next ? a_tile(g, nxt.pm) : cA; const char* nB = has_next ? (const char*)g.Bt + (size_t)nxt.pn * tstepB : cB;
        for (int t = 0; t < nt; t += 2) {
            const bool last = (t == nt - 2);
            const char* a1 = cA + (size_t)(t + 1) * kstep;
            const char* a2 = last ? nA : cA + (size_t)(t + 2) * kstep; const char* b2 = last ? nB : cB + (size_t)(t + 2) * kstep;
            const char* a3 = a2 + kstep; const char* b3 = b2 + kstep;
            PG8_LDB(B0, 0, 0); PG8_LDB(B1, 0, 1); PG8_SCHED; PG8_LDA(At, 0, 0); PG8_STAGE(PG8_SA(1, 1), a1 + hstepA, voffA);
            PG8_WAIT_V(8); PG8_WAIT_L(0); PG8_BAR; PG8_MMA(0, 0, At, B0); PG8_MMA(0, 1, At, B1); PG8_BAR; PG8_SCHED;
            PG8_LDA(At, 0, 1); PG8_STAGE(PG8_SB(0, 0), b2, voffB); PG8_STAGE(PG8_SB(0, 1), b2 + hstepB, voffB); PG8_STAGE(PG8_SA(0, 0), a2, voffA);
            PG8_WAIT_V(8); PG8_WAIT_L(0); PG8_BAR; PG8_MMA(1, 0, At, B0); PG8_MMA(1, 1, At, B1); PG8_BAR; PG8_SCHED;
            PG8_LDB(B0, 1, 0); PG8_LDB(B1, 1, 1); PG8_SCHED; PG8_LDA(At, 1, 0); PG8_STAGE(PG8_SA(0, 1), a2 + hstepA, voffA);
            PG8_WAIT_V(8); PG8_WAIT_L(0); PG8_BAR; PG8_MMA(0, 0, At, B0); PG8_MMA(0, 1, At, B1); PG8_BAR; PG8_SCHED;
            PG8_LDA(At, 1, 1); PG8_STAGE(PG8_SB(1, 0), b3, voffB); PG8_STAGE(PG8_SB(1, 1), b3 + hstepB, voffB); PG8_STAGE(PG8_SA(1, 0), a3, voffA);
            PG8_WAIT_V(8); PG8_WAIT_L(0); PG8_BAR; PG8_MMA(1, 0, At, B0); PG8_MMA(1, 1, At, B1); PG8_BAR; PG8_SCHED;
        }
        if (wr == 0) PG8_BAR;
        if constexpr (!Epi::AFTER_DRAIN) E(acc, cur, wr, wc, fr, fq);
        if (!has_next) break;
#pragma unroll
        for (int a = 0; a < 2; ++a)
#pragma unroll
            for (int b = 0; b < 2; ++b)
#pragma unroll
                for (int m = 0; m < 4; ++m)
#pragma unroll
                    for (int n = 0; n < 2; ++n) acc[a][b][m][n] = (f32x4){0.f, 0.f, 0.f, 0.f};
        cur = nxt; cA = nA; cB = nB; ++ui;
        if (wr == 1) PG8_BAR;
    }
    PG8_WAIT_V(0);
    PG8_BAR;
    if constexpr (Epi::AFTER_DRAIN) E.fused(acc, cur, wr, wc, fr, fq, lds, wid, lane);
#undef PG8_SA
#undef PG8_SB
#undef PG8_STAGE
#undef PG8_LDA
#undef PG8_LDB
#undef PG8_MMA
#undef PG8_WAIT_V
#undef PG8_WAIT_L
#undef PG8_BAR
#undef PG8_SCHED
}

struct EpiP {
    static constexpr bool AFTER_DRAIN = false;
    bf16_t* O; const int* pos; const float* invf; int seg;
    DI void operator()(const f32x4 (&acc)[2][2][4][2], const Unit& u, int wr, int wc, int fr, int fq) const {
        const int kc = u.pn >> 2;
        const int lrow0 = u.pm * BM + wr * 64 + fr;
        const int col0 = u.pn * BM + wc * 32 + 8 * fq;
        if (kc == 5 || kc == 6) {
            const float lg2 = log2f(1.0f - exp2f(-5.0f - (float)(u.pn & 3)));
            const f32x4 f0 = *(const f32x4*)(invf + wc * 32 + 8 * fq), f1 = *(const f32x4*)(invf + wc * 32 + 8 * fq + 4);
#pragma unroll
            for (int ai = 0; ai < 2; ++ai)
#pragma unroll
                for (int m = 0; m < 4; ++m) {
                    const int lrow = lrow0 + ai * HALF + m * 16;
                    const float ps = (float)pos[grow_of(lrow, seg)];
                    const float pc = (float)((lrow & 63) + 1) * lg2;
                    const float sc = (kc == 6) ? 0.0625f * exp2f(-pc) : exp2f(pc);
                    float o1[8], o2[8];
#pragma unroll
                    for (int e = 0; e < 8; ++e) {
                        const float fe = (e < 4) ? f0[e & 3] : f1[e & 3];
                        const float ang = ps * fe;
                        float rev = ang * 0.15915494309189535f; rev = rev - floorf(rev);
                        const float sn = __builtin_amdgcn_sinf(rev), cs = __builtin_amdgcn_cosf(rev);
                        const float a = acc[ai][0][m][e >> 2][e & 3], b = acc[ai][1][m][e >> 2][e & 3];
                        o1[e] = (a * cs - b * sn) * sc; o2[e] = (b * cs + a * sn) * sc;
                    }
                    bf16_t* rowp = O + (size_t)lrow * NPC + col0;
                    u32x4 w1, w2;
                    w1.x = cvt_pk_bf16(o1[0], o1[1]); w1.y = cvt_pk_bf16(o1[2], o1[3]); w1.z = cvt_pk_bf16(o1[4], o1[5]); w1.w = cvt_pk_bf16(o1[6], o1[7]);
                    w2.x = cvt_pk_bf16(o2[0], o2[1]); w2.y = cvt_pk_bf16(o2[2], o2[3]); w2.z = cvt_pk_bf16(o2[4], o2[5]); w2.w = cvt_pk_bf16(o2[6], o2[7]);
                    *(u32x4*)rowp = w1; *(u32x4*)(rowp + HALF) = w2;
                }
        } else if (kc == 3 || kc == 4) {
            const int gcol = 3072 + 128 * (u.pn - 12) + wc * 32 + 8 * fq;
#pragma unroll
            for (int ai = 0; ai < 2; ++ai)
#pragma unroll
                for (int m = 0; m < 4; ++m) {
                    float gv[8];
#pragma unroll
                    for (int e = 0; e < 8; ++e) gv[e] = sigmoidf_(acc[ai][0][m][e >> 2][e & 3]) * siluf_(acc[ai][1][m][e >> 2][e & 3]);
                    u32x4 w; w.x = cvt_pk_bf16(gv[0], gv[1]); w.y = cvt_pk_bf16(gv[2], gv[3]); w.z = cvt_pk_bf16(gv[4], gv[5]); w.w = cvt_pk_bf16(gv[6], gv[7]);
                    *(u32x4*)(O + (size_t)(lrow0 + ai * HALF + m * 16) * NPC + gcol) = w;
                }
        } else {
            const bool act = (kc == 8);
#pragma unroll
            for (int ai = 0; ai < 2; ++ai)
#pragma unroll
                for (int m = 0; m < 4; ++m) {
                    bf16_t* rowp = O + (size_t)(lrow0 + ai * HALF + m * 16) * NPC + col0;
#pragma unroll
                    for (int bj = 0; bj < 2; ++bj) {
                        f32x4 v0 = acc[ai][bj][m][0], v1 = acc[ai][bj][m][1];
                        if (act) {
#pragma unroll
                            for (int e = 0; e < 4; ++e) { v0[e] = siluf_(v0[e]); v1[e] = siluf_(v1[e]); } }
                        u32x4 w; w.x = cvt_pk_bf16(v0[0], v0[1]); w.y = cvt_pk_bf16(v0[2], v0[3]); w.z = cvt_pk_bf16(v1[0], v1[1]); w.w = cvt_pk_bf16(v1[2], v1[3]);
                        *(u32x4*)(rowp + bj * HALF) = w;
                    }
                }
        }
    }
};
struct EpiRes {
    static constexpr bool AFTER_DRAIN = false;
    const float* xin; float* xout; const float* gate; int seg;
    DI void operator()(const f32x4 (&acc)[2][2][4][2], const Unit& u, int wr, int wc, int fr, int fq) const {
        const int b = u.pm / TPB;
        const int lrow0 = u.pm * BM + wr * 64 + fr;
        const int col0 = u.pn * BM + wc * 32 + 8 * fq;
        f32x4 gv[2][2];
#pragma unroll
        for (int bj = 0; bj < 2; ++bj)
#pragma unroll
            for (int n = 0; n < 2; ++n) gv[bj][n] = *(const f32x4*)(gate + b * 3072 + col0 + bj * HALF + 4 * n);
#pragma unroll
        for (int ai = 0; ai < 2; ++ai)
#pragma unroll
            for (int m = 0; m < 4; ++m) {
                const size_t off = (size_t)grow_of(lrow0 + ai * HALF + m * 16, seg) * D + col0;
#pragma unroll
                for (int bj = 0; bj < 2; ++bj)
#pragma unroll
                    for (int n = 0; n < 2; ++n) {
                        const f32x4 xo = *(const f32x4*)(xin + off + bj * HALF + 4 * n);
                        *(f32x4*)(xout + off + bj * HALF + 4 * n) = xo + gv[bj][n] * acc[ai][bj][m][n];
                    }
            }
    }
};
struct EpiResNorm {
    static constexpr bool AFTER_DRAIN = true;
    const float* xin; float* xout; const float* gate; int seg; const float* fg; float* xch; unsigned* cnt;
    DI void operator()(const f32x4 (&)[2][2][4][2], const Unit&, int, int, int, int) const {}
    DI void fused(f32x4 (&acc)[2][2][4][2], const Unit& u, int wr, int wc, int fr, int fq, LAS unsigned char* lds, int wid, int lane) const {
        LAS float* Pp = (LAS float*)lds;
        LAS float* Sr = (LAS float*)(lds + 4096);
        const int b = u.pm / TPB;
        const int lrow0 = u.pm * BM + wr * 64 + fr;
        const int col0 = u.pn * BM + wc * 32 + 8 * fq;
        f32x4 gv[2][2];
#pragma unroll
        for (int bj = 0; bj < 2; ++bj)
#pragma unroll
            for (int n = 0; n < 2; ++n) gv[bj][n] = *(const f32x4*)(gate + b * 3072 + col0 + bj * HALF + 4 * n);
#pragma unroll
        for (int ai = 0; ai < 2; ++ai)
#pragma unroll
            for (int m = 0; m < 4; ++m) {
                const size_t off = (size_t)grow_of(lrow0 + ai * HALF + m * 16, seg) * D + col0;
                float sq = 0.f;
#pragma unroll
                for (int bj = 0; bj < 2; ++bj)
#pragma unroll
                    for (int n = 0; n < 2; ++n) {
                        const f32x4 xo = *(const f32x4*)(xin + off + bj * HALF + 4 * n);
                        const f32x4 v = xo + gv[bj][n] * acc[ai][bj][m][n];
                        acc[ai][bj][m][n] = v; sq += (v[0] * v[0] + v[1] * v[1]) + (v[2] * v[2] + v[3] * v[3]);
                    }
                sq += __shfl_xor(sq, 16); sq += __shfl_xor(sq, 32);
                if (fq == 0) Pp[(ai * HALF + wr * 64 + m * 16 + fr) * 4 + wc] = sq;
            }
        asm volatile("s_waitcnt lgkmcnt(0)" ::: "memory"); __builtin_amdgcn_s_barrier(); asm volatile("" ::: "memory");
        const int panel = seg * 64 + u.pm;
        const int row = wid * 32 + (lane & 31);
        if (lane < 32) {
            const float t = (Pp[row * 4 + 0] + Pp[row * 4 + 1]) + (Pp[row * 4 + 2] + Pp[row * 4 + 3]);
            __hip_atomic_store(xch + ((size_t)panel * 256 + row) * 4 + u.pn, t, __ATOMIC_RELAXED, __HIP_MEMORY_SCOPE_AGENT);
        }
        asm volatile("s_waitcnt vmcnt(0)" ::: "memory");
        if (lane == 0) __hip_atomic_fetch_add(cnt + 16 * panel, 1u, __ATOMIC_RELAXED, __HIP_MEMORY_SCOPE_AGENT);
        if (wid == 0) {
            unsigned sp = 0;
            while ((unsigned)__builtin_amdgcn_readfirstlane((int)__hip_atomic_load(cnt + 16 * panel, __ATOMIC_RELAXED, __HIP_MEMORY_SCOPE_AGENT)) < 32u && ++sp < (1u << 20)) __builtin_amdgcn_s_sleep(1);
        }
        asm volatile("s_waitcnt vmcnt(0) lgkmcnt(0)" ::: "memory"); __builtin_amdgcn_s_barrier(); asm volatile("" ::: "memory");
        if (lane < 32) {
            const float* xp = xch + ((size_t)panel * 256 + row) * 4;
            const float t = (__hip_atomic_load(xp + 0, __ATOMIC_RELAXED, __HIP_MEMORY_SCOPE_AGENT) + __hip_atomic_load(xp + 1, __ATOMIC_RELAXED, __HIP_MEMORY_SCOPE_AGENT))
                          + (__hip_atomic_load(xp + 2, __ATOMIC_RELAXED, __HIP_MEMORY_SCOPE_AGENT) + __hip_atomic_load(xp + 3, __ATOMIC_RELAXED, __HIP_MEMORY_SCOPE_AGENT));
            Sr[row] = 1.0f / sqrtf(t * (1.f / D) + EPS);
        }
        asm volatile("s_waitcnt vmcnt(0) lgkmcnt(0)" ::: "memory"); __builtin_amdgcn_s_barrier(); asm volatile("" ::: "memory");
        f32x4 fgv[2][2];
#pragma unroll
        for (int bj = 0; bj < 2; ++bj)
#pragma unroll
            for (int n = 0; n < 2; ++n) fgv[bj][n] = *(const f32x4*)(fg + col0 + bj * HALF + 4 * n);
#pragma unroll
        for (int ai = 0; ai < 2; ++ai)
#pragma unroll
            for (int m = 0; m < 4; ++m) {
                const int r = ai * HALF + wr * 64 + m * 16 + fr;
                const float rs = Sr[r];
                const size_t off = (size_t)grow_of(u.pm * BM + r, seg) * D + col0;
#pragma unroll
                for (int bj = 0; bj < 2; ++bj)
#pragma unroll
                    for (int n = 0; n < 2; ++n) *(f32x4*)(xout + off + bj * HALF + 4 * n) = (acc[ai][bj][m][n] * rs) * fgv[bj][n];
            }
    }
};
}

DI void p0_transpose_item(const float* W, int ldw, int colsrc, int K, bf16_t* WT, int n0, int k0, LAS float* scr, int lane) {
    float tv_[32];
#pragma unroll
    for (int i = 0; i < 32; ++i) tv_[i] = W[(size_t)(k0 + 2 * i + (lane >> 5)) * ldw + colsrc + (lane & 31)];
#pragma unroll
    for (int i = 0; i < 32; ++i) scr[(2 * i + (lane >> 5)) * 33 + (lane & 31)] = tv_[i];
    asm volatile("s_waitcnt lgkmcnt(0)" ::: "memory");
    const int c = lane & 7;
#pragma unroll
    for (int j = 0; j < 4; ++j) { const int n = (lane >> 3) + 8 * j; const LAS float* s = scr + (8 * c) * 33 + n;
        u32x4 o; o.x = cvt_pk_bf16(s[0 * 33], s[1 * 33]); o.y = cvt_pk_bf16(s[2 * 33], s[3 * 33]); o.z = cvt_pk_bf16(s[4 * 33], s[5 * 33]); o.w = cvt_pk_bf16(s[6 * 33], s[7 * 33]);
        *(u32x4*)(WT + (size_t)(n0 + n) * K + k0 + 8 * c) = o; }
    asm volatile("s_waitcnt lgkmcnt(0)" ::: "memory");
}

DI void phase0(const Params& p, LAS unsigned char* lds, int G, int bid) {
    int tid = threadIdx.x; asm volatile("" : "+v"(tid));
    const int lane = tid & 63, wave = tid >> 6;
    float* ada = (float*)(p.ws + WS_ADA);
    if (bid == 0 && tid < 128) ((float*)(p.ws + WS_INVF))[tid] = (float)(1.0 / pow(10000.0, (double)tid / 127.0));
    for (int i = bid * NT + tid; i < 2 * D * 8; i += G * NT) { const int l_ = i / (D * 8), k_ = (i / 8) % D, c_ = i & 7; ((float*)(p.ws + WS_WG))[i] = p.w_in[(size_t)l_ * D * NSRC + (size_t)k_ * NSRC + 5120 + c_]; }
    LAS float* cact = (LAS float*)lds;
    LAS float* red = (LAS float*)(lds + 16384);
    for (int chunk = bid; chunk < 96; chunk += G) {
        const int l = chunk / 48, c0 = (chunk % 48) * 64;
        for (int i = tid; i < 4096; i += NT) cact[i] = siluf_(p.c[i]);
        __syncthreads();
        const int ksl = tid >> 6, col = tid & 63;
        float a0 = 0.f, a1 = 0.f, a2 = 0.f, a3 = 0.f;
        const float* w = p.w_ada + (size_t)l * D * 3072 + (size_t)(ksl * 128) * 3072 + c0 + col;
#pragma unroll 32
        for (int kk = 0; kk < 128; ++kk) { const float wv = w[(size_t)kk * 3072]; const int k = ksl * 128 + kk;
            a0 += cact[k] * wv; a1 += cact[1024 + k] * wv; a2 += cact[2048 + k] * wv; a3 += cact[3072 + k] * wv; }
        red[(ksl * 4 + 0) * 64 + col] = a0; red[(ksl * 4 + 1) * 64 + col] = a1; red[(ksl * 4 + 2) * 64 + col] = a2; red[(ksl * 4 + 3) * 64 + col] = a3;
        __syncthreads();
        if (tid < 256) { const int b = tid >> 6; float s = p.b_ada[l * 3072 + c0 + col];
#pragma unroll
            for (int q = 0; q < 8; ++q) s += red[(q * 4 + b) * 64 + col];
            ada[(l * 4 + b) * 3072 + c0 + col] = s; }
        __syncthreads();
    }
    __syncthreads();
    LAS float* scr = (LAS float*)(lds + wave * 8704);
    const int gw = bid * 8 + wave, NGW = G * 8;
    constexpr int I_IN = 16 * 288, I_OUT = 32 * 32, I_L = I_IN + I_OUT;
    for (int it = gw; it < 2 * I_L; it += NGW) {
        const int l = it / I_L; int r = it % I_L;
        if (r < I_IN) { const int kb = r / 288, nb = r % 288; const int n0 = nb * 32, tl_ = n0 >> 8, cl_ = n0 & 255;
            const int cs = (tl_ >= 12 && tl_ < 20) ? ((cl_ < 128) ? 3072 + 128 * (tl_ - 12) + cl_ : 4096 + 128 * (tl_ - 12) + cl_ - 128) : (n0 < 5120 ? n0 : n0 + 8);
            p0_transpose_item(p.w_in + (size_t)l * D * NSRC, NSRC, cs, D, (bf16_t*)(p.ws + WS_WIN) + (size_t)l * NPC * D, n0, kb * 64, scr, lane); }
        else { r -= I_IN; const int kb = r / 32, nb = r % 32;
            p0_transpose_item(p.w_out + (size_t)l * 2048 * D, D, nb * 32, 2048, (bf16_t*)(p.ws + WS_WOUT) + (size_t)l * D * 2048, nb * 32, kb * 64, scr, lane); }
    }
}

DI void phase_norm(const Params& p, int l, const float* xin, LAS unsigned char* lds, int G, int bid) {
    int tid = threadIdx.x; asm volatile("" : "+v"(tid));
    const int lane = tid & 63, wave = tid >> 6;
    const int gw = bid * 8 + wave, NGW = G * 8;
    const float* ada = (const float*)(p.ws + WS_ADA) + (size_t)l * 4 * 3072;
    const float* ng = p.norm_g + l * D;
    const float* wg = (const float*)(p.ws + WS_WG) + (size_t)l * D * 8;
    bf16_t* H = (bf16_t*)(p.ws + WS_H);
    float* gates = (float*)(p.ws + WS_GATES);
    LAS float* pa = (LAS float*)lds; LAS float* pb = (LAS float*)(lds + 16384);
    for (int i = tid; i < 4096; i += NT) { const int b_ = i >> 10, k_ = i & 1023; pa[i] = ng[k_] * (1.0f + ada[b_ * 3072 + 1024 + k_]); pb[i] = ada[b_ * 3072 + k_]; }
    __syncthreads();
    f32x4 w0[4][4], w1[4][4];
#pragma unroll
    for (int j = 0; j < 4; ++j)
#pragma unroll
        for (int e = 0; e < 4; ++e) { const int k = 256 * j + 4 * lane + e; w0[j][e] = *(const f32x4*)(wg + (size_t)k * 8); w1[j][e] = *(const f32x4*)(wg + (size_t)k * 8 + 4); }
    f32x4 vn[4];
    if (gw < M) {
#pragma unroll
        for (int j = 0; j < 4; ++j) vn[j] = ((const f32x4*)(xin + (size_t)gw * D) + lane)[64 * j]; }
    for (int row = gw; row < M; row += NGW) {
        const int b = row / S;
        f32x4 v[4]; float ss = 0.f;
#pragma unroll
        for (int j = 0; j < 4; ++j) v[j] = vn[j];
        if (row + NGW < M) {
#pragma unroll
            for (int j = 0; j < 4; ++j) vn[j] = ((const f32x4*)(xin + (size_t)(row + NGW) * D) + lane)[64 * j]; }
#pragma unroll
        for (int j = 0; j < 4; ++j) ss += (v[j].x * v[j].x + v[j].y * v[j].y) + (v[j].z * v[j].z + v[j].w * v[j].w);
        const float rstd = 1.0f / sqrtf(wave_sum(ss) * (1.f / D) + EPS);
        f32x4 g0 = {0.f, 0.f, 0.f, 0.f}, g1 = {0.f, 0.f, 0.f, 0.f};
        unsigned long long* o8 = (unsigned long long*)(H + (size_t)row * D) + lane;
#pragma unroll
        for (int j = 0; j < 4; ++j) {
            const int k = 256 * j + 4 * lane;
            const f32x4 aa = *(const LAS f32x4*)(pa + b * 1024 + k), sh = *(const LAS f32x4*)(pb + b * 1024 + k);
            const f32x4 h = (v[j] * rstd) * aa + sh;
#pragma unroll
            for (int e = 0; e < 4; ++e) { g0 += w0[j][e] * h[e]; g1 += w1[j][e] * h[e]; }
            o8[64 * j] = (unsigned long long)cvt_pk_bf16(h.x, h.y) | ((unsigned long long)cvt_pk_bf16(h.z, h.w) << 32);
        }
#pragma unroll
        for (int e = 0; e < 4; ++e) { g0[e] = wave_sum(g0[e]); g1[e] = wave_sum(g1[e]); }
        if (lane == 0) { *(f32x4*)(gates + (size_t)row * 8) = g0; *(f32x4*)(gates + (size_t)row * 8 + 4) = g1; }
    }
}

DI void tables_stage2(const Params& p, int seg, LAS float* mtab, int bid);
DI void phase_prep(const Params& p, int l, int seg, LAS unsigned char* lds, int G, int bid) {
    LAS float* mtab = (LAS float*)lds;
    tables_stage2(p, seg, mtab, bid);
    int tid = threadIdx.x; asm volatile("" : "+v"(tid));
    const int lane = tid & 63, wave = tid >> 6;
    const bf16_t* P = (const bf16_t*)(p.ws + WS_P);
    bf16_t* QK = (bf16_t*)(p.ws + WS_QK);
    bf16_t* halo = (bf16_t*)(p.ws + WS_HALO);
    const float* cw = p.conv_w + (size_t)l * 4 * 2048; const float* cb = p.conv_b + (size_t)l * 2048;
    for (int it = bid * NT + tid; it < (MSEG / 32) * 256; it += G * NT) {
        const int rb = it >> 8, cgp = it & 255, c0 = cgp * 8;
        const int lrow0 = rb * 32, b = lrow0 / SEG, tt0 = lrow0 % SEG;
        float w[4][8], bias[8];
#pragma unroll
        for (int i = 0; i < 4; ++i) { const f32x4 a = *(const f32x4*)(cw + i * 2048 + c0), c = *(const f32x4*)(cw + i * 2048 + c0 + 4);
#pragma unroll
            for (int e = 0; e < 4; ++e) { w[i][e] = a[e]; w[i][4 + e] = c[e]; } }
        { const f32x4 a = *(const f32x4*)(cb + c0), c = *(const f32x4*)(cb + c0 + 4);
#pragma unroll
            for (int e = 0; e < 4; ++e) { bias[e] = a[e]; bias[4 + e] = c[e]; } }
        const float osc = (c0 >= 1024) ? 0.0625f : 1.f;
        const float* t1p = (const float*)(p.ws + WS_GTAB) + ((c0 & 1023) >> 8) * 4;
        const bool isk = (c0 >= 1024);
        const float mch = mtab[(b * 4 + ((c0 & 1023) >> 8)) * 64 + (tt0 >> 6)];
        u32x4 hraw[3];
#pragma unroll
        for (int i = 0; i < 3; ++i) {
            if (tt0 > 0) hraw[i] = *(const u32x4*)(P + (size_t)(lrow0 - 3 + i) * NPC + c0);
            else if (seg > 0) hraw[i] = *(const u32x4*)(halo + ((size_t)(((seg - 1) & 1) * 4 + b) * 3 + i) * 2048 + c0);
            else hraw[i] = (u32x4){0u, 0u, 0u, 0u};
        }
        float h[3][8];
#pragma unroll
        for (int i = 0; i < 3; ++i)
#pragma unroll
            for (int q = 0; q < 4; ++q) { h[i][2 * q] = bflo(hraw[i][q]); h[i][2 * q + 1] = bfhi(hraw[i][q]); }
        const bool save = (tt0 + 32 == SEG);
        u32x4 rawA[8]; float tA[8];
#pragma unroll
        for (int j = 0; j < 8; ++j) { rawA[j] = *(const u32x4*)(P + (size_t)(lrow0 + j) * NPC + c0); tA[j] = t1p[(size_t)(lrow0 + j) * 16 + (isk ? 1 : 0)]; }
#pragma unroll
        for (int rr = 0; rr < 4; ++rr) {
            u32x4 rawB[8]; float tB[8];
            if (rr < 3) {
#pragma unroll
                for (int j = 0; j < 8; ++j) { rawB[j] = *(const u32x4*)(P + (size_t)(lrow0 + 8 * (rr + 1) + j) * NPC + c0); tB[j] = t1p[(size_t)(lrow0 + 8 * (rr + 1) + j) * 16 + (isk ? 1 : 0)]; }
            }
#pragma unroll
            for (int j = 0; j < 8; ++j) {
                const int r = 8 * rr + j;
                const u32x4 raw = rawA[j];
                float cur[8], o[8];
                const float rsc = osc * (isk ? tA[j] : __expf(-fmaxf(mch, tA[j])));
#pragma unroll
                for (int q = 0; q < 4; ++q) { cur[2 * q] = bflo(raw[q]); cur[2 * q + 1] = bfhi(raw[q]); }
#pragma unroll
                for (int e = 0; e < 8; ++e) { const float y = w[0][e] * h[0][e] + w[1][e] * h[1][e] + w[2][e] * h[2][e] + w[3][e] * cur[e] + bias[e];
                    o[e] = siluf_(y) * rsc; h[0][e] = h[1][e]; h[1][e] = h[2][e]; h[2][e] = cur[e]; }
                u32x4 ov; ov.x = cvt_pk_bf16(o[0], o[1]); ov.y = cvt_pk_bf16(o[2], o[3]); ov.z = cvt_pk_bf16(o[4], o[5]); ov.w = cvt_pk_bf16(o[6], o[7]);
                *(u32x4*)(QK + (size_t)(lrow0 + r) * 2048 + c0) = ov;
                if (save && r >= 29) *(u32x4*)(halo + ((size_t)((seg & 1) * 4 + b) * 3 + (r - 29)) * 2048 + c0) = raw;
            }
            if (rr < 3) {
#pragma unroll
                for (int j = 0; j < 8; ++j) { rawA[j] = rawB[j]; tA[j] = tB[j]; }
            }
        }
    }
}

DI void phase_tables(const Params& p, int l, int seg, int G, int bid) {
    int tid = threadIdx.x; asm volatile("" : "+v"(tid));
    const int lane = tid & 63, wave = tid >> 6;
    const float* gates = (const float*)(p.ws + WS_GATES);
    f32x4* t1 = (f32x4*)(p.ws + WS_GTAB);
    float* t2raw = (float*)(p.ws + WS_T2RAW);
    for (int it = wave * G + bid; it < NB * 4 * NCH; it += 8 * G) {
        const int b = it / (4 * NCH), hh = (it / NCH) & 3, ch = it % NCH;
        const int lrow = b * SEG + ch * 64 + lane, grow = b * S + seg * SEG + ch * 64 + lane;
        const float li = gates[(size_t)grow * 8 + hh] + p.b_ig[l * 4 + hh];
        const float fp = gates[(size_t)grow * 8 + 4 + hh] + p.b_fg[l * 4 + hh];
        const float lf = fminf(fp, 0.f) - log1pf(expf(-fabsf(fp)));
        float bc = lf;
#pragma unroll
        for (int d = 1; d < 64; d <<= 1) { const float t = __shfl_up(bc, d); if (lane >= d) bc += t; }
        const float u = li - bc; float cm = u;
#pragma unroll
        for (int d = 1; d < 64; d <<= 1) { const float t = __shfl_up(cm, d); if (lane >= d) cm = fmaxf(cm, t); }
        t1[(size_t)lrow * 4 + hh] = (f32x4){cm, expf(u), bc, 0.f};
        if (lane == 63) { t2raw[((size_t)(b * NCH + ch) * 4 + hh) * 2] = bc; t2raw[((size_t)(b * NCH + ch) * 4 + hh) * 2 + 1] = cm; }
    }
}
DI void tables_stage2(const Params& p, int seg, LAS float* mtab, int bid) {
    int tid = threadIdx.x; asm volatile("" : "+v"(tid));
    const int lane = tid & 63, wave = tid >> 6;
    const float* t2raw = (const float*)(p.ws + WS_T2RAW);
    f32x4* t2 = (f32x4*)(p.ws + WS_T2);
    float* msave = (float*)(p.ws + WS_MSAVE);
    const bool narrow = (gridDim.x == 256);
    const int t_lo = narrow ? 4 * (bid >> 6) + wave : wave, t_hi = narrow ? (wave < 4 ? t_lo + 1 : 0) : NB * 4;
    const bool pub = narrow ? ((bid & 63) == 0) : (bid == 0);
    for (int t = t_lo; t < t_hi; t += 8) {
        const int b = t >> 2, hh = t & 3;
        const float bL = t2raw[((size_t)(b * NCH + lane) * 4 + hh) * 2], cmL = t2raw[((size_t)(b * NCH + lane) * 4 + hh) * 2 + 1];
        float m = (seg == 0) ? 0.f : msave[seg * 16 + t];
        float mmine = 0.f;
        for (int c = 0; c < NCH; ++c) { const float bl = __builtin_bit_cast(float, __builtin_amdgcn_readlane(__builtin_bit_cast(int, bL), c)), cl = __builtin_bit_cast(float, __builtin_amdgcn_readlane(__builtin_bit_cast(int, cmL), c)); if (lane == c) mmine = m; m = bl + fmaxf(m, cl); }
        mtab[t * 64 + lane] = mmine;
        if (pub) { const float mnew = bL + fmaxf(mmine, cmL);
            t2[(size_t)(b * NCH + lane) * 4 + hh] = (f32x4){expf(bL), expf(bL - mnew), expf(bL + mmine - mnew), mmine};
            if (lane == 0) msave[(seg + 1) * 16 + t] = m; }
    }
    __syncthreads();
}

#define MX_BAR() do { asm volatile("s_waitcnt lgkmcnt(0)" ::: "memory"); __builtin_amdgcn_s_barrier(); asm volatile("" ::: "memory"); } while (0)
constexpr int QP = 528;

constexpr int PS_QI = 0, PS_KI = 64 * QP, PS_VI = 2 * 64 * QP, PS_PI = 3 * 64 * QP, PS_PP = 144, PS_END = PS_PI + 64 * PS_PP;
static_assert(PS_END <= LDS_BYTES - 64, "PS LDS map");
DI void phase_ps(const Params& p, int seg, LAS unsigned char* lds, int G, int bid) {
    int tid = threadIdx.x; asm volatile("" : "+v"(tid));
    const int lane = tid & 63, wave = __builtin_amdgcn_readfirstlane(tid >> 6);
    const int li = wave & 3, ks = wave >> 2;
    bf16_t* P = (bf16_t*)(p.ws + WS_P);
    const bf16_t* QK = (const bf16_t*)(p.ws + WS_QK);
    float* dnb = (float*)(p.ws + WS_DN2);
    const unsigned ldsb = (unsigned)(size_t)lds;
    constexpr int NITEM = 32 * NCH;
    u32x4 pq[4], pk[4], pv[4];
#define PS_LOAD(item_) do { const int st_ = (item_) / NCH, ch_ = (item_) % NCH; const int grp_ = st_ >> 4, b_ = (st_ >> 2) & 3, hh_ = st_ & 3; \
        const bf16_t *qb_, *kb_, *vb_; int qp_; \
        if (grp_ == 0) { qb_ = QK + hh_ * 256; kb_ = QK + 1024 + hh_ * 256; qp_ = 2048; vb_ = P + 2048 + hh_ * 256; } \
        else { qb_ = P + 5120 + hh_ * 256; kb_ = P + 6144 + hh_ * 256; qp_ = NPC; vb_ = P + 7168 + hh_ * 256; } \
        const int r0_ = b_ * SEG + ch_ * 64; int tl_ = tid; asm volatile("" : "+v"(tl_)); \
        _Pragma("unroll") for (int i = 0; i < 4; ++i) { const int idx = tl_ + 512 * i, row = idx >> 5, c16 = idx & 31; \
            pq[i] = *(const u32x4*)(qb_ + (size_t)(r0_ + row) * qp_ + c16 * 8); pk[i] = *(const u32x4*)(kb_ + (size_t)(r0_ + row) * qp_ + c16 * 8); \
            pv[i] = *(const u32x4*)(vb_ + (size_t)(r0_ + row) * NPC + c16 * 8); } } while (0)
    int item = bid;
    if (item < NITEM) PS_LOAD(item);
    for (; item < NITEM; item += G) {
        const int stream = item / NCH, ch = item % NCH;
        const int grp = stream >> 4, b = (stream >> 2) & 3, hh = stream & 3;
        const int lrow0 = b * SEG + ch * 64;
        bf16_t* cellb = P + grp * 1024 + hh * 256;
        { int ts_ = tid; asm volatile("" : "+v"(ts_));
#pragma unroll
          for (int i = 0; i < 4; ++i) { const int idx = ts_ + 512 * i, row = idx >> 5, c16 = idx & 31;
              *(LAS u32x4*)(lds + PS_QI + row * QP + c16 * 16) = pq[i]; *(LAS u32x4*)(lds + PS_KI + row * QP + c16 * 16) = pk[i]; *(LAS u32x4*)(lds + PS_VI + row * QP + c16 * 16) = pv[i]; } }
        if (item + G < NITEM) PS_LOAD(item + G);
        MX_BAR();
        { int ln = lane; asm volatile("" : "+v"(ln)); const int i16 = ln & 15, g4 = ln >> 4; const int lq = 16 * li + i16;
          f32x4 sa0 = {0.f, 0.f, 0.f, 0.f}, sa1 = {0.f, 0.f, 0.f, 0.f};
          if (2 * ks <= li) {
              bf16x8 qf[8], ka[8], kb[8];
#pragma unroll
              for (int kk = 0; kk < 8; ++kk) { qf[kk] = *(const LAS bf16x8*)(lds + PS_QI + lq * QP + 64 * kk + 16 * g4);
                  ka[kk] = *(const LAS bf16x8*)(lds + PS_KI + (32 * ks + i16) * QP + 64 * kk + 16 * g4);
                  kb[kk] = *(const LAS bf16x8*)(lds + PS_KI + (32 * ks + 16 + i16) * QP + 64 * kk + 16 * g4); }
              __builtin_amdgcn_sched_barrier(0);
#pragma unroll
              for (int kk = 0; kk < 8; ++kk) { sa0 = __builtin_amdgcn_mfma_f32_16x16x32_bf16(ka[kk], qf[kk], sa0, 0, 0, 0);
                  sa1 = __builtin_amdgcn_mfma_f32_16x16x32_bf16(kb[kk], qf[kk], sa1, 0, 0, 0); }
          }
          float pw[8];
#pragma unroll
          for (int r = 0; r < 4; ++r) { const int s0 = 32 * ks + 4 * g4 + r; pw[r] = (s0 <= lq) ? sa0[r] : 0.f; pw[4 + r] = (s0 + 16 <= lq) ? sa1[r] : 0.f; }
          u32x2 w0, w1; w0.x = cvt_pk_bf16(pw[0], pw[1]); w0.y = cvt_pk_bf16(pw[2], pw[3]); w1.x = cvt_pk_bf16(pw[4], pw[5]); w1.y = cvt_pk_bf16(pw[6], pw[7]);
          *(LAS u32x2*)(lds + PS_PI + lq * PS_PP + (32 * ks + 4 * g4) * 2) = w0;
          *(LAS u32x2*)(lds + PS_PI + lq * PS_PP + (32 * ks + 16 + 4 * g4) * 2) = w1; }
        MX_BAR();
        { int ln = lane; asm volatile("" : "+v"(ln)); const int i16 = ln & 15, g4 = ln >> 4;
          s16x4 t[8];
          const unsigned va = ldsb + PS_VI + (8 * g4 + (i16 >> 2)) * QP + (2 * wave) * 32 + 8 * (ln & 3);
          asm volatile("ds_read_b64_tr_b16 %0, %8\n\tds_read_b64_tr_b16 %1, %8 offset:2112\n\tds_read_b64_tr_b16 %2, %8 offset:16896\n\tds_read_b64_tr_b16 %3, %8 offset:19008\n\t"
                       "ds_read_b64_tr_b16 %4, %8 offset:32\n\tds_read_b64_tr_b16 %5, %8 offset:2144\n\tds_read_b64_tr_b16 %6, %8 offset:16928\n\tds_read_b64_tr_b16 %7, %8 offset:19040\n\ts_waitcnt lgkmcnt(0)"
                       : "=&v"(t[0]), "=&v"(t[1]), "=&v"(t[2]), "=&v"(t[3]), "=&v"(t[4]), "=&v"(t[5]), "=&v"(t[6]), "=&v"(t[7]) : "v"(va) : "memory");
          bf16x8 pf[4][2];
#pragma unroll
          for (int lt = 0; lt < 4; ++lt)
#pragma unroll
              for (int kk = 0; kk < 2; ++kk) pf[lt][kk] = *(const LAS bf16x8*)(lds + PS_PI + (16 * lt + i16) * PS_PP + 64 * kk + 16 * g4);
          __builtin_amdgcn_sched_barrier(0);
#pragma unroll
          for (int a = 0; a < 2; ++a) {
              const bf16x8 v0 = __builtin_shufflevector(t[4 * a], t[4 * a + 1], 0, 1, 2, 3, 4, 5, 6, 7), v1 = __builtin_shufflevector(t[4 * a + 2], t[4 * a + 3], 0, 1, 2, 3, 4, 5, 6, 7);
#pragma unroll
              for (int lt = 0; lt < 4; ++lt) {
                  f32x4 o = __builtin_amdgcn_mfma_f32_16x16x32_bf16(v0, pf[lt][0], (f32x4){0.f, 0.f, 0.f, 0.f}, 0, 0, 0);
                  o = __builtin_amdgcn_mfma_f32_16x16x32_bf16(v1, pf[lt][1], o, 0, 0, 0);
                  u32x2 w; w.x = cvt_pk_bf16(o[0], o[1]); w.y = cvt_pk_bf16(o[2], o[3]);
                  *(u32x2*)(cellb + (size_t)(lrow0 + 16 * lt + i16) * NPC + 16 * (2 * wave + a) + 4 * g4) = w;
              }
          }
          if (grp == 0 && wave == 0) { float sum = 0.f;
#pragma unroll
              for (int c = 0; c < 8; ++c) { const u32x4 pr = *(const LAS u32x4*)(lds + PS_PI + ln * PS_PP + 16 * c);
#pragma unroll
                  for (int q = 0; q < 4; ++q) sum += bflo(pr[q]) + bfhi(pr[q]); }
              dnb[(size_t)(lrow0 + ln) * 4 + hh] = sum; }
        }
        MX_BAR();
    }
#undef PS_LOAD
}

constexpr int VP2 = 112;
constexpr int L_QI = 0, L_KI = 64 * QP, L_CI = 2 * 64 * QP, L_VI = L_CI + 48 * QP, L_RED = L_VI + 64 * VP2, L_MXEND = L_RED + 4 * 12 * 64 * 4;
static_assert(L_MXEND <= LDS_BYTES - 64, "mixer LDS map");
DI void phase_mixer(const Params& p, int seg, LAS unsigned char* lds, int G, int bid) {
    int tid = threadIdx.x; asm volatile("" : "+v"(tid));
    const int lane = tid & 63, wave = __builtin_amdgcn_readfirstlane(tid >> 6);
    const int li = wave & 3, ks = wave >> 2;
    bf16_t* P = (bf16_t*)(p.ws + WS_P);
    const bf16_t* QK = (const bf16_t*)(p.ws + WS_QK);
    const f32x4* t1 = (const f32x4*)(p.ws + WS_GTAB);
    const f32x4* t2 = (const f32x4*)(p.ws + WS_T2);
    float* dnb = (float*)(p.ws + WS_DN);
    const float* dn2 = (const float*)(p.ws + WS_DN2);
    float* csave = (float*)(p.ws + WS_CSAVE);
    const unsigned ldsb = (unsigned)(size_t)lds;

    for (int item = bid; item < 256; item += G) {
        const int stream = (item >> 5) * 4 + (item & 3), vs = (item & 31) >> 2;
        const int grp = stream >> 4, b = (stream >> 2) & 3, hh = stream & 3;
        const bool stab = (grp == 0);
        constexpr int nvt = 3;
        const bf16_t *qb, *kb, *vb; int qpitch;
        if (grp == 0) { qb = QK + hh * 256; kb = QK + 1024 + hh * 256; qpitch = 2048; vb = P + 2048 + hh * 256 + vs * 32; }
        else { qb = P + 5120 + hh * 256; kb = P + 6144 + hh * 256; qpitch = NPC; vb = P + 7168 + hh * 256 + vs * 32; }
        bf16_t* cellb = P + grp * 1024 + hh * 256 + vs * 32;
        const int lrowb = b * SEG;
        const float gdec = exp2f(64.0f * log2f(1.0f - exp2f(-5.0f - (float)hh)));
#define MX_G(ch_) (stab ? ((const float*)(t2 + (size_t)(b * NCH + (ch_)) * 4 + hh))[0] : gdec)
#define MX_MCH(ch_) (((const float*)(t2 + (size_t)(b * NCH + (ch_)) * 4 + hh))[3])

        f32x4 C[2][3];
        if (seg == 0) {
#pragma unroll
            for (int a = 0; a < 2; ++a)
#pragma unroll
                for (int v = 0; v < 3; ++v) C[a][v] = (f32x4){0.f, 0.f, 0.f, 0.f};
        } else {
#pragma unroll
            for (int a = 0; a < 2; ++a)
#pragma unroll
                for (int v = 0; v < 3; ++v) C[a][v] = *(const f32x4*)(csave + ((size_t)item * 6 + a * 3 + v) * 2048 + tid * 4);
        }
        for (int i = tid; i < 64 * 8; i += NT) { const int r = i >> 3, c2 = i & 7; *(LAS unsigned*)(lds + L_VI + r * VP2 + 64 + c2 * 4) = (c2 == 0) ? 0x00003F80u : 0u; }
#define MX_WRITE_CIMG(em_) do { int lnC = lane; const int i16 = lnC & 15, g4 = lnC >> 4; const float e_ = (em_); _Pragma("unroll") for (int a = 0; a < 2; ++a) _Pragma("unroll") for (int v = 0; v < 3; ++v) { if (v < nvt) { \
            u32x2 w; (void)e_; w.x = cvt_pk_bf16(C[a][v][0], C[a][v][1]); w.y = cvt_pk_bf16(C[a][v][2], C[a][v][3]); \
            *(LAS u32x2*)(lds + L_CI + (16 * v + i16) * QP + (16 * (2 * wave + a) + 4 * g4) * 2) = w; } } } while (0)
        float g_c = MX_G(0);
        MX_WRITE_CIMG(1.0f);

        u32x4 pq[4], pk[4], pv; u32x2 pin[2]; float pden = 0.f, pcm = 0.f, pbc = 0.f, pmch = 0.f;
        const unsigned voq = (unsigned)(((tid >> 5) * qpitch + (tid & 31) * 8) * 2);
        const unsigned vov = (unsigned)(((tid >> 2) * NPC + (tid & 3) * 8) * 2);
        const unsigned vop = (unsigned)(((16 * ((tid >> 6) & 3) + (tid & 15)) * NPC + 4 * ((tid & 63) >> 4)) * 2);
        const size_t qstep16 = (size_t)16 * qpitch * 2;
        const __amdgpu_buffer_rsrc_t wsr = __builtin_amdgcn_make_buffer_rsrc(p.ws, 0, 0x7fffffff, 0x00020000);
        const int oq0 = (int)((const char*)qb - (const char*)p.ws), ok0 = (int)((const char*)kb - (const char*)p.ws), ov0 = (int)((const char*)vb - (const char*)p.ws), oc0 = (int)((const char*)cellb - (const char*)p.ws);
        const int qs16 = 16 * qpitch * 2;
#define MX_LOADQ(ch) do { const int r0_ = lrowb + (ch) * 64; const int sq_ = oq0 + r0_ * qpitch * 2; \
            _Pragma("unroll") for (int i = 0; i < 4; ++i) pq[i] = __builtin_amdgcn_raw_buffer_load_b128(wsr, voq, sq_ + i * qs16, 0); \
            if (tid < 256) { const int sc_ = oc0 + r0_ * NPC * 2; \
                pin[0] = __builtin_amdgcn_raw_buffer_load_b64(wsr, vop, sc_, 0); pin[1] = __builtin_amdgcn_raw_buffer_load_b64(wsr, vop, sc_ + 32, 0); \
                if (stab && vs == 0 && ((tid & 63) >> 4) == 0) { const int lr_ = r0_ + 16 * ((tid >> 6) & 3) + (tid & 15); pden = dn2[(size_t)lr_ * 4 + hh]; const float* tk_ = (const float*)(t1 + (size_t)lr_ * 4 + hh); pcm = tk_[0]; pbc = tk_[2]; pmch = MX_MCH(ch); } } } while (0)
#define MX_LOADK(ch) do { const int r0_ = lrowb + (ch) * 64; const int sk_ = ok0 + r0_ * qpitch * 2; \
            _Pragma("unroll") for (int i = 0; i < 4; ++i) pk[i] = __builtin_amdgcn_raw_buffer_load_b128(wsr, voq, sk_ + i * qs16, 0); \
            if (tid < 256) pv = __builtin_amdgcn_raw_buffer_load_b128(wsr, vov, ov0 + r0_ * NPC * 2, 0); } while (0)
#define MX_STAGEQ() do { int ts_ = tid; \
            _Pragma("unroll") for (int i = 0; i < 4; ++i) { const int idx = ts_ + 512 * i, row = idx >> 5, c16 = idx & 31; \
                *(LAS u32x4*)(lds + L_QI + row * QP + c16 * 16) = pq[i]; } } while (0)
#define MX_STAGEK(cs_) do { int ts_ = tid; const float c_ = (cs_); \
            _Pragma("unroll") for (int i = 0; i < 4; ++i) { const int idx = ts_ + 512 * i, row = idx >> 5, c16 = idx & 31; \
                *(LAS u32x4*)(lds + L_KI + row * QP + c16 * 16) = pk[i]; } \
            if (ts_ < 256) { const int s_ = ts_ >> 2, c4_ = ts_ & 3; (void)c_; \
                *(LAS u32x4*)(lds + L_VI + s_ * VP2 + c4_ * 16) = pv; } } while (0)

        u32x2 cin[2]; float cden = 0.f, cemr = 1.f;
        MX_LOADQ(0);
        MX_LOADK(0);
        MX_STAGEQ();
        cin[0] = pin[0]; cin[1] = pin[1]; cden = pden; cemr = __expf(-(pbc + fmaxf(pmch, pcm)));
        MX_BAR();
        for (int ch = 0; ch < NCH; ++ch) {
            float g_n = 1.f;
            if (ch + 1 < NCH) { g_n = MX_G(ch + 1); MX_LOADQ(ch + 1); }
            int lnA = lane;
            const int i16 = lnA & 15, g4 = lnA >> 4;
            const int lq = 16 * li + i16;
            bf16x8 qf[4], cf[3][4];
#pragma unroll
            for (int k4 = 0; k4 < 4; ++k4) qf[k4] = *(const LAS bf16x8*)(lds + L_QI + lq * QP + 64 * (4 * ks + k4) + 16 * g4);
#pragma unroll
            for (int v = 0; v < 3; ++v)
#pragma unroll
                for (int k4 = 0; k4 < 4; ++k4) cf[v][k4] = *(const LAS bf16x8*)(lds + L_CI + (16 * v + i16) * QP + 64 * (4 * ks + k4) + 16 * g4);
            __builtin_amdgcn_sched_barrier(0);
            f32x4 num[3];
#pragma unroll
            for (int v = 0; v < 3; ++v) num[v] = (f32x4){0.f, 0.f, 0.f, 0.f};
            if (ks == 0) { num[0] = (f32x4){bflo(cin[0].x), bfhi(cin[0].x), bflo(cin[0].y), bfhi(cin[0].y)};
                num[1] = (f32x4){bflo(cin[1].x), bfhi(cin[1].x), bflo(cin[1].y), bfhi(cin[1].y)}; num[2][0] = cden; }
#pragma unroll
            for (int k4 = 0; k4 < 4; ++k4)
#pragma unroll
                for (int v = 0; v < 3; ++v) if (v < nvt) num[v] = __builtin_amdgcn_mfma_f32_16x16x32_bf16(cf[v][k4], qf[k4], num[v], 0, 0, 0);
            if (ks == 1) {
#pragma unroll
                for (int v = 0; v < 3; ++v)
#pragma unroll
                    for (int r = 0; r < 4; ++r) *(LAS float*)(lds + L_RED + ((li * 12 + v * 4 + r) * 64 + lnA) * 4) = num[v][r];
            }
            MX_STAGEK(1.0f);
            if (ch + 1 < NCH) MX_LOADK(ch + 1);
            MX_BAR();
            if (ks == 0) {
#pragma unroll
                for (int v = 0; v < 3; ++v)
#pragma unroll
                    for (int r = 0; r < 4; ++r) num[v][r] += *(const LAS float*)(lds + L_RED + ((li * 12 + v * 4 + r) * 64 + lnA) * 4);
                const int lrow = lrowb + ch * 64 + lq;
#pragma unroll
                for (int v = 0; v < 2; ++v) { u32x2 w; w.x = cvt_pk_bf16(num[v][0], num[v][1]); w.y = cvt_pk_bf16(num[v][2], num[v][3]);
                    __builtin_amdgcn_raw_buffer_store_b64(w, wsr, vop, oc0 + (lrowb + ch * 64) * NPC * 2 + 32 * v, 0); }
                if (stab && vs == 0 && g4 == 0) dnb[(size_t)lrow * 4 + hh] = fmaxf(fabsf(num[2][0]), cemr);
            }
            {
                s16x4 t0[4], t1r[4], tv[12];
                int lnB = lane;
                const int j16 = lnB & 15, h4 = lnB >> 4;
                const unsigned addr0 = ldsb + L_KI + (8 * h4 + (j16 >> 2)) * QP + (2 * wave) * 32 + 8 * (lnB & 3);
                const unsigned addrv = ldsb + L_VI + (8 * h4 + (j16 >> 2)) * VP2 + 8 * (lnB & 3);
                asm volatile("ds_read_b64_tr_b16 %0, %8\n\tds_read_b64_tr_b16 %1, %8 offset:2112\n\tds_read_b64_tr_b16 %2, %8 offset:16896\n\tds_read_b64_tr_b16 %3, %8 offset:19008\n\t"
                             "ds_read_b64_tr_b16 %4, %8 offset:32\n\tds_read_b64_tr_b16 %5, %8 offset:2144\n\tds_read_b64_tr_b16 %6, %8 offset:16928\n\tds_read_b64_tr_b16 %7, %8 offset:19040\n\ts_waitcnt lgkmcnt(0)"
                             : "=&v"(t0[0]), "=&v"(t0[1]), "=&v"(t0[2]), "=&v"(t0[3]), "=&v"(t1r[0]), "=&v"(t1r[1]), "=&v"(t1r[2]), "=&v"(t1r[3]) : "v"(addr0) : "memory");
                asm volatile("ds_read_b64_tr_b16 %0, %12\n\tds_read_b64_tr_b16 %1, %12 offset:448\n\tds_read_b64_tr_b16 %2, %12 offset:3584\n\tds_read_b64_tr_b16 %3, %12 offset:4032\n\t"
                             "ds_read_b64_tr_b16 %4, %12 offset:32\n\tds_read_b64_tr_b16 %5, %12 offset:480\n\tds_read_b64_tr_b16 %6, %12 offset:3616\n\tds_read_b64_tr_b16 %7, %12 offset:4064\n\t"
                             "ds_read_b64_tr_b16 %8, %12 offset:64\n\tds_read_b64_tr_b16 %9, %12 offset:512\n\tds_read_b64_tr_b16 %10, %12 offset:3648\n\tds_read_b64_tr_b16 %11, %12 offset:4096\n\ts_waitcnt lgkmcnt(0)"
                             : "=&v"(tv[0]), "=&v"(tv[1]), "=&v"(tv[2]), "=&v"(tv[3]), "=&v"(tv[4]), "=&v"(tv[5]), "=&v"(tv[6]), "=&v"(tv[7]), "=&v"(tv[8]), "=&v"(tv[9]), "=&v"(tv[10]), "=&v"(tv[11]) : "v"(addrv) : "memory");
                __builtin_amdgcn_sched_barrier(0);
#pragma unroll
                for (int v = 0; v < 3; ++v) if (v < nvt) {
                    const bf16x8 vb0 = __builtin_shufflevector(tv[4 * v], tv[4 * v + 1], 0, 1, 2, 3, 4, 5, 6, 7);
                    C[0][v] = __builtin_amdgcn_mfma_f32_16x16x32_bf16(__builtin_shufflevector(t0[0], t0[1], 0, 1, 2, 3, 4, 5, 6, 7), vb0, C[0][v], 0, 0, 0);
                    C[1][v] = __builtin_amdgcn_mfma_f32_16x16x32_bf16(__builtin_shufflevector(t1r[0], t1r[1], 0, 1, 2, 3, 4, 5, 6, 7), vb0, C[1][v], 0, 0, 0); }
#pragma unroll
                for (int v = 0; v < 3; ++v) if (v < nvt) {
                    const bf16x8 vb1 = __builtin_shufflevector(tv[4 * v + 2], tv[4 * v + 3], 0, 1, 2, 3, 4, 5, 6, 7);
                    C[0][v] = __builtin_amdgcn_mfma_f32_16x16x32_bf16(__builtin_shufflevector(t0[2], t0[3], 0, 1, 2, 3, 4, 5, 6, 7), vb1, C[0][v], 0, 0, 0);
                    C[1][v] = __builtin_amdgcn_mfma_f32_16x16x32_bf16(__builtin_shufflevector(t1r[2], t1r[3], 0, 1, 2, 3, 4, 5, 6, 7), vb1, C[1][v], 0, 0, 0); }
            }
#pragma unroll
            for (int a = 0; a < 2; ++a)
#pragma unroll
                for (int v = 0; v < 3; ++v) C[a][v] = C[a][v] * g_c;
            MX_WRITE_CIMG(1.0f);
            if (ch + 1 < NCH) { MX_STAGEQ(); cin[0] = pin[0]; cin[1] = pin[1]; cden = pden; cemr = __expf(-(pbc + fmaxf(pmch, pcm))); }
            MX_BAR();
            g_c = g_n;
        }
        if (seg + 1 < NSEG) {
#pragma unroll
            for (int a = 0; a < 2; ++a)
#pragma unroll
                for (int v = 0; v < 3; ++v) *(f32x4*)(csave + ((size_t)item * 6 + a * 3 + v) * 2048 + tid * 4) = C[a][v];
        }
        __syncthreads();
#undef MX_WRITE_CIMG
#undef MX_LOADQ
#undef MX_LOADK
#undef MX_STAGEQ
#undef MX_STAGEK
#undef MX_G
#undef MX_MCH
    }
}

DI void phase_post(const Params& p, int l, int G, int bid) {
    int tid = threadIdx.x; asm volatile("" : "+v"(tid));
    const int lane = tid & 63, wave = tid >> 6;
    bf16_t* P = (bf16_t*)(p.ws + WS_P);
    const float* dnb = (const float*)(p.ws + WS_DN);
    const int hh = lane >> 4;
    f32x4 gnm[4], gnr[4];
#pragma unroll
    for (int q = 0; q < 4; ++q) { gnm[q] = *(const f32x4*)(p.gn_m + l * 1024 + 16 * lane + 4 * q); gnr[q] = *(const f32x4*)(p.gn_r + l * 1024 + 16 * lane + 4 * q); }
    u32x4 nc0, nc1, nz0, nz1, no0 = {0u, 0u, 0u, 0u}, no1 = {0u, 0u, 0u, 0u}; float ndn = 1.f;
#define PP_LOAD(it_) do { const int lr_ = (it_) >> 1, gp_ = (it_) & 1; const bf16_t* rp_ = P + (size_t)lr_ * NPC + 16 * lane; \
        nc0 = *(const u32x4*)(rp_ + gp_ * 1024); nc1 = *(const u32x4*)(rp_ + gp_ * 1024 + 8); \
        nz0 = *(const u32x4*)(rp_ + (gp_ == 0 ? 3072 : 8192)); nz1 = *(const u32x4*)(rp_ + (gp_ == 0 ? 3072 : 8192) + 8); \
        if (gp_ == 0) ndn = dnb[(size_t)lr_ * 4 + hh]; } while (0)
    if (bid * 8 + wave < MSEG * 2) PP_LOAD(bid * 8 + wave);
    for (int it = bid * 8 + wave; it < MSEG * 2; it += G * 8) {
        const int lrow = it >> 1, grp = it & 1;
        bf16_t* cp = P + (size_t)lrow * NPC + grp * 1024 + 16 * lane;
        const u32x4 c0 = nc0, c1 = nc1, z0 = nz0, z1 = nz1, o0 = no0, o1 = no1;
        const float inv = (grp == 0) ? 1.0f / ndn : 1.f;
        if (it + G * 8 < MSEG * 2) PP_LOAD(it + G * 8);
        float h[16], sum = 0.f;
#pragma unroll
        for (int q = 0; q < 4; ++q) { h[2 * q] = bflo(c0[q]) * inv; h[2 * q + 1] = bfhi(c0[q]) * inv; h[8 + 2 * q] = bflo(c1[q]) * inv; h[8 + 2 * q + 1] = bfhi(c1[q]) * inv; }
#pragma unroll
        for (int e = 0; e < 16; ++e) sum += h[e];
#pragma unroll
        for (int o = 1; o < 16; o <<= 1) sum += __shfl_xor(sum, o);
        const float mu = sum * (1.f / 256.f);
        float q2 = 0.f;
#pragma unroll
        for (int e = 0; e < 16; ++e) { h[e] -= mu; q2 += h[e] * h[e]; }
#pragma unroll
        for (int o = 1; o < 16; o <<= 1) q2 += __shfl_xor(q2, o);
        const float rstd = 1.0f / sqrtf(q2 * (1.f / 256.f) + EPS);
        float y[16];
#pragma unroll
        for (int q = 0; q < 4; ++q) {
            const f32x4 gn = (grp == 0) ? gnm[q] : gnr[q];
            const unsigned zz0 = (q < 2) ? z0[2 * q] : z1[2 * q - 4], zz1 = (q < 2) ? z0[2 * q + 1] : z1[2 * q - 3];
            const unsigned oo0 = (q < 2) ? o0[2 * q] : o1[2 * q - 4], oo1 = (q < 2) ? o0[2 * q + 1] : o1[2 * q - 3];
            const float zv[4] = {bflo(zz0), bfhi(zz0), bflo(zz1), bfhi(zz1)};
            const float ov[4] = {bflo(oo0), bfhi(oo0), bflo(oo1), bfhi(oo1)};
#pragma unroll
            for (int e = 0; e < 4; ++e) y[4 * q + e] = (h[4 * q + e] * rstd * gn[e]) * zv[e];
        }
        u32x4 w0, w1;
        w0.x = cvt_pk_bf16(y[0], y[1]); w0.y = cvt_pk_bf16(y[2], y[3]); w0.z = cvt_pk_bf16(y[4], y[5]); w0.w = cvt_pk_bf16(y[6], y[7]);
        w1.x = cvt_pk_bf16(y[8], y[9]); w1.y = cvt_pk_bf16(y[10], y[11]); w1.z = cvt_pk_bf16(y[12], y[13]); w1.w = cvt_pk_bf16(y[14], y[15]);
        *(u32x4*)cp = w0; *(u32x4*)(cp + 8) = w1;
    }
#undef PP_LOAD
}

DI void phase_final(const Params& p, int G, int bid) {
    int tid = threadIdx.x; asm volatile("" : "+v"(tid));
    const int lane = tid & 63, wave = tid >> 6;
    f32x4 vn[4];
    if (bid * 8 + wave < M) {
#pragma unroll
        for (int j = 0; j < 4; ++j) vn[j] = ((const f32x4*)(p.out + (size_t)(bid * 8 + wave) * D) + lane)[64 * j]; }
    f32x4 fg[4];
#pragma unroll
    for (int j = 0; j < 4; ++j) fg[j] = *(const f32x4*)(p.final_g + 256 * j + 4 * lane);
    for (int row = bid * 8 + wave; row < M; row += G * 8) {
        f32x4* xr = (f32x4*)(p.out + (size_t)row * D) + lane;
        f32x4 v[4]; float ss = 0.f;
#pragma unroll
        for (int j = 0; j < 4; ++j) v[j] = vn[j];
        if (row + G * 8 < M) {
#pragma unroll
            for (int j = 0; j < 4; ++j) vn[j] = ((const f32x4*)(p.out + (size_t)(row + G * 8) * D) + lane)[64 * j]; }
#pragma unroll
        for (int j = 0; j < 4; ++j) ss += (v[j].x * v[j].x + v[j].y * v[j].y) + (v[j].z * v[j].z + v[j].w * v[j].w);
        const float rstd = 1.0f / sqrtf(wave_sum(ss) * (1.f / D) + EPS);
#pragma unroll
        for (int j = 0; j < 4; ++j) xr[64 * j] = (v[j] * rstd) * fg[j];
    }
}

constexpr size_t WS_BAR = 0;
#define XB_TMO      128
#define XB_XCNT(j)  (256  + 64 * (j))
#define XB_XSUB(j)  (1280 + 64 * (j))
#define XB_XGEN(j)  (2304 + 64 * (j))
#define XB_TOP      3328
#define XB_TOPGEN   3392
#define XCD_BAR_WORDS 3456
#define XB_SPIN_CAP (1u << 22)
DI unsigned xb_ld(unsigned* p)              { return __hip_atomic_load(p, __ATOMIC_RELAXED, __HIP_MEMORY_SCOPE_AGENT); }
DI unsigned xb_add(unsigned* p, unsigned v) { return __hip_atomic_fetch_add(p, v, __ATOMIC_RELAXED, __HIP_MEMORY_SCOPE_AGENT); }
DI unsigned xb_xcc_id() { return (unsigned)__builtin_amdgcn_s_getreg((3 << 11) | 20) & 0xFu; }
#define XB_SPIN(cond, bar) do { unsigned _sp = 0; while (cond) { __builtin_amdgcn_s_sleep(1); \
    if ((++_sp & 255u) == 0u) { if (xb_ld(&(bar)[XB_TMO])) break; if (_sp > XB_SPIN_CAP) { atomicAdd(&(bar)[XB_TMO], 1u); break; } } } } while (0)
struct XcdBarrier { unsigned* bar; unsigned x; volatile LAS unsigned* st; };
DI XcdBarrier xcd_barrier_post(unsigned* bar, volatile LAS unsigned* st) {
    XcdBarrier b; b.bar = bar; b.x = xb_xcc_id(); b.st = st;
    if (threadIdx.x == 0) (void)xb_add(&bar[XB_XCNT(b.x)], 1u);
    return b;
}
DI void xcd_barrier_complete(unsigned* bar, unsigned x, unsigned& nloc, unsigned& nx) {
    const unsigned G = gridDim.x * gridDim.y * gridDim.z;
    unsigned sum, cnt, mine, sp = 0u;
    for (;;) {
        sum = 0u; cnt = 0u; mine = 0u;
#pragma unroll
        for (unsigned j = 0; j < 16; ++j) { const unsigned c = xb_ld(&bar[XB_XCNT(j)]); sum += c; cnt += (c > 0u) ? 1u : 0u; mine = (j == x) ? c : mine; }
        if (sum == G) break;
        __builtin_amdgcn_s_sleep(1);
        if ((++sp & 255u) == 0u) { if (xb_ld(&bar[XB_TMO])) break; if (sp > XB_SPIN_CAP) { atomicAdd(&bar[XB_TMO], 1u); break; } }
    }
    nloc = mine > 0u ? mine : 1u; nx = cnt > 0u ? cnt : 1u;
}
DI void xcd_barrier(const XcdBarrier& b) {
    asm volatile("s_waitcnt vmcnt(0)" ::: "memory");
    __syncthreads();
    if (threadIdx.x == 0) {
        unsigned* bar = b.bar;
        __builtin_amdgcn_s_waitcnt(0);
        unsigned nloc = b.st[0], nx = b.st[1];
        if (nloc == 0u) { xcd_barrier_complete(bar, b.x, nloc, nx); b.st[0] = nloc; b.st[1] = nx; }
        const unsigned old = xb_add(&bar[XB_XSUB(b.x)], 1u);
        const unsigned gen = old / nloc;
        if (old + 1u == (gen + 1u) * nloc) {
            __builtin_amdgcn_fence(__ATOMIC_RELEASE, "agent");
            asm volatile("s_waitcnt vmcnt(0)" ::: "memory");
            const unsigned og = xb_add(&bar[XB_TOP], 1u);
            const unsigned tg = og / nx;
            if (og + 1u == (tg + 1u) * nx) xb_add(&bar[XB_TOPGEN], 1u);
            else XB_SPIN(xb_ld(&bar[XB_TOPGEN]) == tg, bar);
            __builtin_amdgcn_fence(__ATOMIC_ACQUIRE, "agent");
            xb_add(&bar[XB_XGEN(b.x)], 1u);
            asm volatile("s_waitcnt vmcnt(0)" ::: "memory");
        } else {
            XB_SPIN(xb_ld(&bar[XB_XGEN(b.x)]) == gen, bar);
            __builtin_amdgcn_fence(__ATOMIC_ACQUIRE, "agent");
            asm volatile("s_waitcnt vmcnt(0)" ::: "memory");
        }
    }
    __syncthreads();
}

static_assert(NCH == 64, "tables_stage2 maps chunks to lanes");
constexpr int N_PHASES = 28;
constexpr int REP_P0 = 1, REP_PN = 1, REP_G1 = 1, REP_PE = 1, REP_MX = 1;
__global__ void __launch_bounds__(NT, 2) fwd_megakernel(Params p) {
    extern __shared__ __attribute__((aligned(16))) unsigned char lds_raw[];
    LAS unsigned char* lds = (LAS unsigned char*)lds_raw;
    cg::grid_group grid = cg::this_grid();
    const int G = gridDim.x, bid = blockIdx.x;
    const int lo = p.ph_lo;
    const bool fuse_pf = (G == 256) && (p.ph_lo == 0) && (p.ph_hi == N_PHASES);
    const int hi = fuse_pf ? p.ph_hi - 1 : p.ph_hi;
    int ph = 0, nsync = 0;
    volatile LAS unsigned* xst = (volatile LAS unsigned*)(lds + LDS_BYTES - 16);
    if (threadIdx.x < 4) xst[threadIdx.x] = 0u;
    __syncthreads();
    XcdBarrier xbar = xcd_barrier_post((unsigned*)(p.ws + WS_BAR), xst);
    unsigned* slotw = (unsigned*)(p.ws + WS_BAR) + XCD_BAR_WORDS;
    if (threadIdx.x == 0) { const unsigned xc = xb_xcc_id() & 7u; xst[2] = xc; xst[3] = xb_add(&slotw[64 * xc], 1u); }
#define GSYNC() do { if (lo < 0) grid.sync(); else xcd_barrier(xbar); ++nsync; } while (0)
#define RUNR(rep, ...) do { if (ph >= lo && ph < hi) { for (int r_ = 0; r_ < (rep); ++r_) { __VA_ARGS__; if (r_ + 1 < (rep) || ph + 1 < hi) GSYNC(); } } ++ph; } while (0)
#define RUN(...) RUNR(1, __VA_ARGS__)
    RUNR(REP_P0, phase0(p, lds, G, bid));
    int vb = bid, vc = bid;
    if (G == 256 && lo == 0 && hi > 1) {
        bool ok = true;
        for (int j = 0; j < 8; ++j) ok = ok && (xb_ld(&slotw[64 * j]) == 32u);
        if (ok) { const int xc = (int)xst[2], sl = (int)xst[3]; vb = xc * 32 + sl; vc = sl * 8 + xc; }
    }
    vb = __builtin_amdgcn_readfirstlane(vb); vc = __builtin_amdgcn_readfirstlane(vc);
    for (int l = 0; l < 2; ++l) {
        const float* xin = (l == 0) ? p.x : p.out;
        RUNR(REP_PN, phase_norm(p, l, xin, lds, G, bid));
        for (int seg = 0; seg < NSEG; ++seg) {
            RUNR(REP_G1, { phase_tables(p, l, seg, G, bid); pg8::Gemm g{(const bf16_t*)(p.ws + WS_H), (const bf16_t*)(p.ws + WS_WIN) + (size_t)l * NPC * D, D, D, MSEG / 256, NPC / 256, seg, 0};
                  pg8::EpiP E{(bf16_t*)(p.ws + WS_P), p.pos, (const float*)(p.ws + WS_INVF), seg};
                  pg8::gemm_phase(lds, g, G, vc, E); });
            RUNR(REP_PE, phase_prep(p, l, seg, lds, G, bid));
            RUN(phase_ps(p, seg, lds, G, bid));
            RUNR(REP_MX, phase_mixer(p, seg, lds, G, vb));
            RUN(phase_post(p, l, G, bid));
            RUN({ pg8::Gemm g{(const bf16_t*)(p.ws + WS_P), (const bf16_t*)(p.ws + WS_WOUT) + (size_t)l * D * 2048, NPC, 2048, MSEG / 256, D / 256, seg, 1};
                  if (fuse_pf && l == 1) {
                      pg8::EpiResNorm E{xin, p.out, (const float*)(p.ws + WS_ADA) + (size_t)l * 4 * 3072 + 2048, seg, p.final_g, (float*)(p.ws + WS_XCH), (unsigned*)(p.ws + WS_XCNT)};
                      pg8::gemm_phase(lds, g, G, vc, E);
                  } else {
                      pg8::EpiRes E{xin, p.out, (const float*)(p.ws + WS_ADA) + (size_t)l * 4 * 3072 + 2048, seg};
                      pg8::gemm_phase(lds, g, G, vc, E);
                  } });
        }
    }
    RUN(phase_final(p, G, bid));
#undef RUN
#undef RUNR
#undef GSYNC
}

#ifndef MK_SPLIT
#define MK_SPLIT 0
#endif
extern "C" void kernel_launch(void* const* d_in, const int* in_sizes, int n_in, void* d_out, int out_size, void* d_ws, size_t ws_size, hipStream_t stream) {
    static int grid = 0;
    if (grid == 0) {
        int dev = 0, cus = 0, per_cu = 0;
        (void)hipGetDevice(&dev);
        (void)hipDeviceGetAttribute(&cus, hipDeviceAttributeMultiprocessorCount, dev);
        (void)hipFuncSetAttribute((const void*)fwd_megakernel, hipFuncAttributeMaxDynamicSharedMemorySize, LDS_BYTES);
        (void)hipOccupancyMaxActiveBlocksPerMultiprocessor(&per_cu, (const void*)fwd_megakernel, NT, LDS_BYTES);
        if (per_cu < 1) per_cu = 1;
        grid = cus * 1;
        if (ws_size < WS_END) { fprintf(stderr, "kernel_launch: workspace too small (%zu < %zu)\n", ws_size, (size_t)WS_END); grid = -1; }
    }
    if (grid < 0) return;
    Params p{};
    p.x = (const float*)d_in[0]; p.c = (const float*)d_in[1]; p.pos = (const int*)d_in[2]; p.w_ada = (const float*)d_in[3]; p.b_ada = (const float*)d_in[4];
    p.norm_g = (const float*)d_in[5]; p.w_in = (const float*)d_in[6]; p.conv_w = (const float*)d_in[7]; p.conv_b = (const float*)d_in[8];
    p.b_ig = (const float*)d_in[9]; p.b_fg = (const float*)d_in[10]; p.gn_m = (const float*)d_in[11]; p.gn_r = (const float*)d_in[12];
    p.w_out = (const float*)d_in[13]; p.final_g = (const float*)d_in[14];
    p.out = (float*)d_out; p.ws = (unsigned char*)d_ws;
#if MK_SPLIT
    for (int ph = 0; ph < N_PHASES; ++ph) { p.ph_lo = ph; p.ph_hi = ph + 1; hipLaunchKernelGGL(fwd_megakernel, dim3(grid), dim3(NT), LDS_BYTES, stream, p); }
#else
    p.ph_lo = 0; p.ph_hi = N_PHASES;
    (void)hipMemsetAsync((char*)d_ws + WS_BAR, 0, 32768, stream);
    void* args[] = {&p};
    hipError_t e = hipLaunchCooperativeKernel((const void*)fwd_megakernel, dim3(grid), dim3(NT), args, LDS_BYTES, stream);
    if (e != hipSuccess) fprintf(stderr, "cooperative launch failed: %s (grid %d)\n", hipGetErrorString(e), grid);
#endif
}
```

```cpp
#include <hip/hip_runtime.h>
#include <hip/hip_cooperative_groups.h>
#include <cstdint>
#include <cstdio>
namespace cg = cooperative_groups;

#define LAS __attribute__((address_space(3)))
#define DI __device__ __forceinline__
typedef unsigned short bf16_t;
typedef short bf16x8 __attribute__((ext_vector_type(8)));
typedef short s16x4 __attribute__((ext_vector_type(4)));
typedef float f32x4 __attribute__((ext_vector_type(4)));
typedef unsigned u32x4 __attribute__((ext_vector_type(4)));
typedef unsigned u32x2 __attribute__((ext_vector_type(2)));

constexpr int NB = 4, S = 8192, D = 1024, M = NB * S;
constexpr int NPC = 9216;
constexpr int NSRC = 9224;
constexpr int NSEG = 2, SEG = S / NSEG, MSEG = NB * SEG, TPB = SEG / 256, NCH = SEG / 64;
constexpr int NT = 512;
constexpr float EPS = 1e-6f;

constexpr size_t MiB = 1u << 20;
constexpr size_t WS_ADA = 1 * MiB;
constexpr size_t WS_INVF = WS_ADA + 128 * 1024;
constexpr size_t WS_WG = 1 * MiB + 512 * 1024;
constexpr size_t WS_HALO = WS_INVF + 4096;
constexpr size_t WS_MSAVE = WS_HALO + 128 * 1024;
constexpr size_t WS_GATES = 2 * MiB;
constexpr size_t WS_GTAB = 3 * MiB;
constexpr size_t WS_T2 = 4 * MiB + 512 * 1024;
constexpr size_t WS_T2RAW = 4 * MiB + 768 * 1024;
constexpr size_t WS_DN = 5 * MiB;
constexpr size_t WS_DN2 = 5 * MiB + 512 * 1024;
constexpr size_t WS_WIN = 16 * MiB;
constexpr size_t WS_WOUT = 52 * MiB;
constexpr size_t WS_H = 64 * MiB;
constexpr size_t WS_QK = 128 * MiB;
constexpr size_t WS_P = 192 * MiB;
constexpr size_t WS_CSAVE = 480 * MiB;
constexpr size_t WS_XCH = 6 * MiB;
constexpr size_t WS_XCNT = 16384;
constexpr size_t WS_END = 512 * MiB;

constexpr int LDS_BYTES = 147456;

struct Params {
    const float* x; const float* c; const int* pos; const float* w_ada; const float* b_ada; const float* norm_g;
    const float* w_in; const float* conv_w; const float* conv_b; const float* b_ig; const float* b_fg;
    const float* gn_m; const float* gn_r; const float* w_out; const float* final_g;
    float* out; unsigned char* ws;
    int ph_lo, ph_hi;
};

typedef __bf16 bf16v2_t __attribute__((ext_vector_type(2)));
DI unsigned cvt_pk_bf16(float lo, float hi) { bf16v2_t v; v[0] = (__bf16)lo; v[1] = (__bf16)hi; return __builtin_bit_cast(unsigned, v); }
DI float bflo(unsigned u) { return __builtin_bit_cast(float, u << 16); }
DI float bfhi(unsigned u) { return __builtin_bit_cast(float, u & 0xffff0000u); }
DI float wave_sum(float v) {
#pragma unroll
    for (int o = 1; o < 64; o <<= 1) v += __shfl_xor(v, o);
    return v;
}
DI float sigmoidf_(float x) { return __builtin_amdgcn_rcpf(1.f + __expf(-x)); }
DI float siluf_(float x) { return x * __builtin_amdgcn_rcpf(1.f + __expf(-x)); }
DI int grow_of(int lrow, int seg) { return (lrow / SEG) * S + seg * SEG + (lrow % SEG); }

namespace pg8 {
constexpr int BM = 256, BK = 64, HALF = 128, HTB = HALF * BK * 2, NXCD = 8, WGM = 4;
__host__ __device__ __forceinline__ int lds_byte(int r, int c) { const int st = (r >> 4) * 2 + (c >> 5), rr = r & 15, cc = c & 31, ob = rr * 64 + cc * 2; return st * 1024 + (ob ^ (((ob >> 9) & 1) << 5)); }
__host__ __device__ __forceinline__ void stage_rc(int b, int& R, int& C) { const int st = b / 1024, sb = b % 1024, swz = sb ^ (((sb >> 9) & 1) << 5); R = (st >> 1) * 16 + swz / 64; C = (st & 1) * 32 + (swz % 64) / 2; }
__host__ __device__ __forceinline__ int perm32(int rho) { const int n = rho >> 4, i = rho & 15; return 8 * (i >> 2) + 4 * n + (i & 3); }

struct Unit { int pm, pn; };
struct Gemm { const bf16_t* A; const bf16_t* Bt; int lda, K, nM, nN, seg, amode; };

struct StaticOrder {
    int nM, nN, nwg, G, c;
    DI void init(int nM_, int nN_, int G_, int c_) { nM = nM_; nN = nN_; nwg = nM * nN; G = G_; c = c_; }
    DI bool next(int i, Unit& u) const {
        const long L = (long)i * G + c; if (L >= nwg) return false;
        int wgid = (int)L; { const int q = nwg / NXCD, r = nwg % NXCD, xcd = wgid % NXCD, off = wgid / NXCD; wgid = (xcd < r ? xcd * (q + 1) : r * (q + 1) + (xcd - r) * q) + off; }
        const int nig = WGM * nN, gid = wgid / nig, fm = gid * WGM, gsz = (nM - fm) < WGM ? (nM - fm) : WGM;
        u.pm = fm + ((wgid % nig) % gsz); u.pn = (wgid % nig) / gsz; return true;
    }
};

DI const char* a_tile(const Gemm& g, int pm) {
    const int rowbase = g.amode ? pm * BM : grow_of(pm * BM, g.seg);
    return (const char*)g.A + (size_t)rowbase * g.lda * 2;
}

template <class Epi>
DI void gemm_phase(LAS unsigned char* lds, const Gemm g, int G, int c, const Epi& E) {
    int tid = threadIdx.x; asm volatile("" : "+v"(tid));
    const int wid = __builtin_amdgcn_readfirstlane(tid >> 6), lane = tid & 63, wr = wid >> 2, wc = wid & 3, fr = lane & 15, fq = lane >> 4;
    const int K = g.K, nt = K / BK;
    unsigned voffA[2], voffB[2];
#pragma unroll
    for (int i = 0; i < 2; ++i) { int R, C; stage_rc(tid * 16 + i * 8192, R, C); const int Rb = (R & ~31) + perm32(R & 31);
        voffA[i] = (unsigned)(R * g.lda + C) * 2u; voffB[i] = (unsigned)(Rb * K + C) * 2u; }
    const size_t kstep = (size_t)(BK * 2);
    const size_t hstepA = (size_t)HALF * g.lda * 2, hstepB = (size_t)HALF * K * 2, tstepB = 2 * hstepB;
    const unsigned ldsw = (unsigned)wid * 1024u;
    const int aoff = lds_byte(wr * 64 + fr, fq * 8), boff = lds_byte(wc * 32 + fr, fq * 8);
#define PG8_SA(b, h) (((b) * 2 + (h)) * HTB)
#define PG8_SB(b, h) ((4 + (b) * 2 + (h)) * HTB)
#define PG8_STAGE(bufoff, gbase, voff) do { _Pragma("unroll") for (int _i = 0; _i < 2; ++_i) \
        __builtin_amdgcn_global_load_lds((const unsigned*)((const char*)(gbase) + (voff)[_i]), (LAS unsigned*)(lds + (bufoff) + ldsw + _i * 8192), 16, 0, 0); } while (0)
#define PG8_LDA(dst, b, h) do { _Pragma("unroll") for (int m = 0; m < 4; ++m) _Pragma("unroll") for (int k = 0; k < 2; ++k) dst[m][k] = *(const LAS bf16x8*)(lds + PG8_SA(b, h) + aoff + m * 2048 + k * 1024); } while (0)
#define PG8_LDB(dst, b, h) do { _Pragma("unroll") for (int n = 0; n < 2; ++n) _Pragma("unroll") for (int k = 0; k < 2; ++k) dst[n][k] = *(const LAS bf16x8*)(lds + PG8_SB(b, h) + boff + n * 2048 + k * 1024); } while (0)
#define PG8_MMA(ai, bj, At, Bt) do { __builtin_amdgcn_s_setprio(1); _Pragma("unroll") for (int m = 0; m < 4; ++m) _Pragma("unroll") for (int n = 0; n < 2; ++n) _Pragma("unroll") for (int k = 0; k < 2; ++k) \
        acc[ai][bj][m][n] = __builtin_amdgcn_mfma_f32_16x16x32_bf16(Bt[n][k], At[m][k], acc[ai][bj][m][n], 0, 0, 0); __builtin_amdgcn_s_setprio(0); } while (0)
#define PG8_WAIT_V(n) asm volatile("s_waitcnt vmcnt(" #n ")" ::: "memory")
#define PG8_WAIT_L(n) asm volatile("s_waitcnt lgkmcnt(" #n ")" ::: "memory")
#define PG8_BAR __builtin_amdgcn_s_barrier()
#define PG8_SCHED __builtin_amdgcn_sched_barrier(0)
    StaticOrder S; S.init(g.nM, g.nN, G, c);
    Unit cur, nxt; int ui = 0;
    if (!S.next(0, cur)) return;
    f32x4 acc[2][2][4][2];
#pragma unroll
    for (int a = 0; a < 2; ++a)
#pragma unroll
        for (int b = 0; b < 2; ++b)
#pragma unroll
            for (int m = 0; m < 4; ++m)
#pragma unroll
                for (int n = 0; n < 2; ++n) acc[a][b][m][n] = (f32x4){0.f, 0.f, 0.f, 0.f};
    bf16x8 At[4][2], B0[2][2], B1[2][2];
    const char* cA = a_tile(g, cur.pm); const char* cB = (const char*)g.Bt + (size_t)cur.pn * tstepB;
    PG8_STAGE(PG8_SB(0, 0), cB, voffB); PG8_STAGE(PG8_SB(0, 1), cB + hstepB, voffB); PG8_STAGE(PG8_SA(0, 0), cA, voffA); PG8_STAGE(PG8_SA(0, 1), cA + hstepA, voffA);
    if (wr == 1) PG8_BAR;
    PG8_WAIT_V(2); PG8_BAR;
    PG8_STAGE(PG8_SB(1, 0), cB + kstep, voffB); PG8_STAGE(PG8_SA(1, 0), cA + kstep, voffA); PG8_STAGE(PG8_SB(1, 1), cB + hstepB + kstep, voffB);
    PG8_WAIT_V(6); PG8_BAR;
    for (;;) {
        const bool has_next = S.next(ui + 1, nxt);
        const char* nA = has_next ? a_tile(g, nxt.pm) : cA; const char* nB = has_next ? (const char*)g.Bt + (size_t)nxt.pn * tstepB : cB;
        for (int t = 0; t < nt; t += 2) {
            const bool last = (t == nt - 2);
            const char* a1 = cA + (size_t)(t + 1) * kstep;
            const char* a2 = last ? nA : cA + (size_t)(t + 2) * kstep; const char* b2 = last ? nB : cB + (size_t)(t + 2) * kstep;
            const char* a3 = a2 + kstep; const char* b3 = b2 + kstep;
            PG8_LDB(B0, 0, 0); PG8_LDB(B1, 0, 1); PG8_SCHED; PG8_LDA(At, 0, 0); PG8_STAGE(PG8_SA(1, 1), a1 + hstepA, voffA);
            PG8_WAIT_V(8); PG8_WAIT_L(0); PG8_BAR; PG8_MMA(0, 0, At, B0); PG8_MMA(0, 1, At, B1); PG8_BAR; PG8_SCHED;
            PG8_LDA(At, 0, 1); PG8_STAGE(PG8_SB(0, 0), b2, voffB); PG8_STAGE(PG8_SB(0, 1), b2 + hstepB, voffB); PG8_STAGE(PG8_SA(0, 0), a2, voffA);
            PG8_WAIT_V(8); PG8_WAIT_L(0); PG8_BAR; PG8_MMA(1, 0, At, B0); PG8_MMA(1, 1, At, B1); PG8_BAR; PG8_SCHED;
            PG8_LDB(B0, 1, 0); PG8_LDB(B1, 1, 1); PG8_SCHED; PG8_LDA(At, 1, 0); PG8_STAGE(PG8_SA(0, 1), a2 + hstepA, voffA);
            PG8_WAIT_V(8); PG8_WAIT_L(0); PG8_BAR; PG8_MMA(0, 0, At, B0); PG8_MMA(0, 1, At, B1); PG8_BAR; PG8_SCHED;
            PG8_LDA(At, 1, 1); PG8_STAGE(PG8_SB(1, 0), b3, voffB); PG8_STAGE(PG8_SB(1, 1), b3 + hstepB, voffB); PG8_STAGE(PG8_SA(1, 0), a3, voffA);
            PG8_WAIT_V(8); PG8_WAIT_L(0); PG8_BAR; PG8_MMA(1, 0, At, B0); PG8_MMA(1, 1, At, B1); PG8_BAR; PG8_SCHED;
        }
        if (wr == 0) PG8_BAR;
        if constexpr (!Epi::AFTER_DRAIN) E(acc, cur, wr, wc, fr, fq);
        if (!has_next) break;
#pragma unroll
        for (int a = 0; a < 2; ++a)
#pragma unroll
            for (int b = 0; b < 2; ++b)
#pragma unroll
                for (int m = 0; m < 4; ++m)
#pragma unroll
                    for (int n = 0; n < 2; ++n) acc[a][b][m][n] = (f32x4){0.f, 0.f, 0.f, 0.f};
        cur = nxt; cA = nA; cB = nB; ++ui;
        if (wr == 1) PG8_BAR;
    }
    PG8_WAIT_V(0);
    PG8_BAR;
    if constexpr (Epi::AFTER_DRAIN) E.fused(acc, cur, wr, wc, fr, fq, lds, wid, lane);
#undef PG8_SA
#undef PG8_SB
#undef PG8_STAGE
#undef PG8_LDA
#undef PG8_LDB
#undef PG8_MMA
#undef PG8_WAIT_V
#undef PG8_WAIT_L
#undef PG8_BAR
#undef PG8_SCHED
}

struct EpiP {
    static constexpr bool AFTER_DRAIN = false;
    bf16_t* O; const int* pos; const float* invf; int seg;
    DI void operator()(const f32x4 (&acc)[2][2][4][2], const Unit& u, int wr, int wc, int fr, int fq) const {
        const int kc = u.pn >> 2;
        const int lrow0 = u.pm * BM + wr * 64 + fr;
        const int col0 = u.pn * BM + wc * 32 + 8 * fq;
        if (kc == 5 || kc == 6) {
            const float lg2 = log2f(1.0f - exp2f(-5.0f - (float)(u.pn & 3)));
            const f32x4 f0 = *(const f32x4*)(invf + wc * 32 + 8 * fq), f1 = *(const f32x4*)(invf + wc * 32 + 8 * fq + 4);
#pragma unroll
            for (int ai = 0; ai < 2; ++ai)
#pragma unroll
                for (int m = 0; m < 4; ++m) {
                    const int lrow = lrow0 + ai * HALF + m * 16;
                    const float ps = (float)pos[grow_of(lrow, seg)];
                    const float pc = (float)((lrow & 63) + 1) * lg2;
                    const float sc = (kc == 6) ? 0.0625f * exp2f(-pc) : exp2f(pc);
                    float o1[8], o2[8];
#pragma unroll
                    for (int e = 0; e < 8; ++e) {
                        const float fe = (e < 4) ? f0[e & 3] : f1[e & 3];
                        const float ang = ps * fe;
                        float rev = ang * 0.15915494309189535f; rev = rev - floorf(rev);
                        const float sn = __builtin_amdgcn_sinf(rev), cs = __builtin_amdgcn_cosf(rev);
                        const float a = acc[ai][0][m][e >> 2][e & 3], b = acc[ai][1][m][e >> 2][e & 3];
                        o1[e] = (a * cs - b * sn) * sc; o2[e] = (b * cs + a * sn) * sc;
                    }
                    bf16_t* rowp = O + (size_t)lrow * NPC + col0;
                    u32x4 w1, w2;
                    w1.x = cvt_pk_bf16(o1[0], o1[1]); w1.y = cvt_pk_bf16(o1[2], o1[3]); w1.z = cvt_pk_bf16(o1[4], o1[5]); w1.w = cvt_pk_bf16(o1[6], o1[7]);
                    w2.x = cvt_pk_bf16(o2[0], o2[1]); w2.y = cvt_pk_bf16(o2[2], o2[3]); w2.z = cvt_pk_bf16(o2[4], o2[5]); w2.w = cvt_pk_bf16(o2[6], o2[7]);
                    *(u32x4*)rowp = w1; *(u32x4*)(rowp + HALF) = w2;
                }
        } else if (kc == 3 || kc == 4) {
            const int gcol = 3072 + 128 * (u.pn - 12) + wc * 32 + 8 * fq;
#pragma unroll
            for (int ai = 0; ai < 2; ++ai)
#pragma unroll
                for (int m = 0; m < 4; ++m) {
                    float gv[8];
#pragma unroll
                    for (int e = 0; e < 8; ++e) gv[e] = sigmoidf_(acc[ai][0][m][e >> 2][e & 3]) * siluf_(acc[ai][1][m][e >> 2][e & 3]);
                    u32x4 w; w.x = cvt_pk_bf16(gv[0], gv[1]); w.y = cvt_pk_bf16(gv[2], gv[3]); w.z = cvt_pk_bf16(gv[4], gv[5]); w.w = cvt_pk_bf16(gv[6], gv[7]);
                    *(u32x4*)(O + (size_t)(lrow0 + ai * HALF + m * 16) * NPC + gcol) = w;
                }
        } else {
            const bool act = (kc == 8);
#pragma unroll
            for (int ai = 0; ai < 2; ++ai)
#pragma unroll
                for (int m = 0; m < 4; ++m) {
                    bf16_t* rowp = O + (size_t)(lrow0 + ai * HALF + m * 16) * NPC + col0;
#pragma unroll
                    for (int bj = 0; bj < 2; ++bj) {
                        f32x4 v0 = acc[ai][bj][m][0], v1 = acc[ai][bj][m][1];
                        if (act) {
#pragma unroll
                            for (int e = 0; e < 4; ++e) { v0[e] = siluf_(v0[e]); v1[e] = siluf_(v1[e]); } }
                        u32x4 w; w.x = cvt_pk_bf16(v0[0], v0[1]); w.y = cvt_pk_bf16(v0[2], v0[3]); w.z = cvt_pk_bf16(v1[0], v1[1]); w.w = cvt_pk_bf16(v1[2], v1[3]);
                        *(u32x4*)(rowp + bj * HALF) = w;
                    }
                }
        }
    }
};
struct EpiRes {
    static constexpr bool AFTER_DRAIN = false;
    const float* xin; float* xout; const float* gate; int seg;
    DI void operator()(const f32x4 (&acc)[2][2][4][2], const Unit& u, int wr, int wc, int fr, int fq) const {
        const int b = u.pm / TPB;
        const int lrow0 = u.pm * BM + wr * 64 + fr;
        const int col0 = u.pn * BM + wc * 32 + 8 * fq;
        f32x4 gv[2][2];
#pragma unroll
        for (int bj = 0; bj < 2; ++bj)
#pragma unroll
            for (int n = 0; n < 2; ++n) gv[bj][n] = *(const f32x4*)(gate + b * 3072 + col0 + bj * HALF + 4 * n);
#pragma unroll
        for (int ai = 0; ai < 2; ++ai)
#pragma unroll
            for (int m = 0; m < 4; ++m) {
                const size_t off = (size_t)grow_of(lrow0 + ai * HALF + m * 16, seg) * D + col0;
#pragma unroll
                for (int bj = 0; bj < 2; ++bj)
#pragma unroll
                    for (int n = 0; n < 2; ++n) {
                        const f32x4 xo = *(const f32x4*)(xin + off + bj * HALF + 4 * n);
                        *(f32x4*)(xout + off + bj * HALF + 4 * n) = xo + gv[bj][n] * acc[ai][bj][m][n];
                    }
            }
    }
};
struct EpiResNorm {
    static constexpr bool AFTER_DRAIN = true;
    const float* xin; float* xout; const float* gate; int seg; const float* fg; float* xch; unsigned* cnt;
    DI void operator()(const f32x4 (&)[2][2][4][2], const Unit&, int, int, int, int) const {}
    DI void fused(f32x4 (&acc)[2][2][4][2], const Unit& u, int wr, int wc, int fr, int fq, LAS unsigned char* lds, int wid, int lane) const {
        LAS float* Pp = (LAS float*)lds;
        LAS float* Sr = (LAS float*)(lds + 4096);
        const int b = u.pm / TPB;
        const int lrow0 = u.pm * BM + wr * 64 + fr;
        const int col0 = u.pn * BM + wc * 32 + 8 * fq;
        f32x4 gv[2][2];
#pragma unroll
        for (int bj = 0; bj < 2; ++bj)
#pragma unroll
            for (int n = 0; n < 2; ++n) gv[bj][n] = *(const f32x4*)(gate + b * 3072 + col0 + bj * HALF + 4 * n);
#pragma unroll
        for (int ai = 0; ai < 2; ++ai)
#pragma unroll
            for (int m = 0; m < 4; ++m) {
                const size_t off = (size_t)grow_of(lrow0 + ai * HALF + m * 16, seg) * D + col0;
                float sq = 0.f;
#pragma unroll
                for (int bj = 0; bj < 2; ++bj)
#pragma unroll
                    for (int n = 0; n < 2; ++n) {
                        const f32x4 xo = *(const f32x4*)(xin + off + bj * HALF + 4 * n);
                        const f32x4 v = xo + gv[bj][n] * acc[ai][bj][m][n];
                        acc[ai][bj][m][n] = v; sq += (v[0] * v[0] + v[1] * v[1]) + (v[2] * v[2] + v[3] * v[3]);
                    }
                sq += __shfl_xor(sq, 16); sq += __shfl_xor(sq, 32);
                if (fq == 0) Pp[(ai * HALF + wr * 64 + m * 16 + fr) * 4 + wc] = sq;
            }
        asm volatile("s_waitcnt lgkmcnt(0)" ::: "memory"); __builtin_amdgcn_s_barrier(); asm volatile("" ::: "memory");
        const int panel = seg * 64 + u.pm;
        const int row = wid * 32 + (lane & 31);
        if (lane < 32) {
            const float t = (Pp[row * 4 + 0] + Pp[row * 4 + 1]) + (Pp[row * 4 + 2] + Pp[row * 4 + 3]);
            __hip_atomic_store(xch + ((size_t)panel * 256 + row) * 4 + u.pn, t, __ATOMIC_RELAXED, __HIP_MEMORY_SCOPE_AGENT);
        }
        asm volatile("s_waitcnt vmcnt(0)" ::: "memory");
        if (lane == 0) __hip_atomic_fetch_add(cnt + 16 * panel, 1u, __ATOMIC_RELAXED, __HIP_MEMORY_SCOPE_AGENT);
        if (wid == 0) {
            unsigned sp = 0;
            while ((unsigned)__builtin_amdgcn_readfirstlane((int)__hip_atomic_load(cnt + 16 * panel, __ATOMIC_RELAXED, __HIP_MEMORY_SCOPE_AGENT)) < 32u && ++sp < (1u << 20)) __builtin_amdgcn_s_sleep(1);
        }
        asm volatile("s_waitcnt vmcnt(0) lgkmcnt(0)" ::: "memory"); __builtin_amdgcn_s_barrier(); asm volatile("" ::: "memory");
        if (lane < 32) {
            const float* xp = xch + ((size_t)panel * 256 + row) * 4;
            const float t = (__hip_atomic_load(xp + 0, __ATOMIC_RELAXED, __HIP_MEMORY_SCOPE_AGENT) + __hip_atomic_load(xp + 1, __ATOMIC_RELAXED, __HIP_MEMORY_SCOPE_AGENT))
                          + (__hip_atomic_load(xp + 2, __ATOMIC_RELAXED, __HIP_MEMORY_SCOPE_AGENT) + __hip_atomic_load(xp + 3, __ATOMIC_RELAXED, __HIP_MEMORY_SCOPE_AGENT));
            Sr[row] = 1.0f / sqrtf(t * (1.f / D) + EPS);
        }
        asm volatile("s_waitcnt vmcnt(0) lgkmcnt(0)" ::: "memory"); __builtin_amdgcn_s_barrier(); asm volatile("" ::: "memory");
        f32x4 fgv[2][2];
#pragma unroll
        for (int bj = 0; bj < 2; ++bj)
#pragma unroll
            for (int n = 0; n < 2; ++n) fgv[bj][n] = *(const f32x4*)(fg + col0 + bj * HALF + 4 * n);
#pragma unroll
        for (int ai = 0; ai < 2; ++ai)
#pragma unroll
            for (int m = 0; m < 4; ++m) {
                const int r = ai * HALF + wr * 64 + m * 16 + fr;
                const float rs = Sr[r];
                const size_t off = (size_t)grow_of(u.pm * BM + r, seg) * D + col0;
#pragma unroll
                for (int bj = 0; bj < 2; ++bj)
#pragma unroll
                    for (int n = 0; n < 2; ++n) *(f32x4*)(xout + off + bj * HALF + 4 * n) = (acc[ai][bj][m][n] * rs) * fgv[bj][n];
            }
    }
};
}

DI void p0_transpose_item(const float* W, int ldw, int colsrc, int K, bf16_t* WT, int n0, int k0, LAS float* scr, int lane) {
    float tv_[32];
#pragma unroll
    for (int i = 0; i < 32; ++i) tv_[i] = W[(size_t)(k0 + 2 * i + (lane >> 5)) * ldw + colsrc + (lane & 31)];
#pragma unroll
    for (int i = 0; i < 32; ++i) scr[(2 * i + (lane >> 5)) * 33 + (lane & 31)] = tv_[i];
    asm volatile("s_waitcnt lgkmcnt(0)" ::: "memory");
    const int c = lane & 7;
#pragma unroll
    for (int j = 0; j < 4; ++j) { const int n = (lane >> 3) + 8 * j; const LAS float* s = scr + (8 * c) * 33 + n;
        u32x4 o; o.x = cvt_pk_bf16(s[0 * 33], s[1 * 33]); o.y = cvt_pk_bf16(s[2 * 33], s[3 * 33]); o.z = cvt_pk_bf16(s[4 * 33], s[5 * 33]); o.w = cvt_pk_bf16(s[6 * 33], s[7 * 33]);
        *(u32x4*)(WT + (size_t)(n0 + n) * K + k0 + 8 * c) = o; }
    asm volatile("s_waitcnt lgkmcnt(0)" ::: "memory");
}

DI void phase0(const Params& p, LAS unsigned char* lds, int G, int bid) {
    int tid = threadIdx.x; asm volatile("" : "+v"(tid));
    const int lane = tid & 63, wave = tid >> 6;
    float* ada = (float*)(p.ws + WS_ADA);
    if (bid == 0 && tid < 128) ((float*)(p.ws + WS_INVF))[tid] = (float)(1.0 / pow(10000.0, (double)tid / 127.0));
    for (int i = bid * NT + tid; i < 2 * D * 8; i += G * NT) { const int l_ = i / (D * 8), k_ = (i / 8) % D, c_ = i & 7; ((float*)(p.ws + WS_WG))[i] = p.w_in[(size_t)l_ * D * NSRC + (size_t)k_ * NSRC + 5120 + c_]; }
    LAS float* cact = (LAS float*)lds;
    LAS float* red = (LAS float*)(lds + 16384);
    for (int chunk = bid; chunk < 96; chunk += G) {
        const int l = chunk / 48, c0 = (chunk % 48) * 64;
        for (int i = tid; i < 4096; i += NT) cact[i] = siluf_(p.c[i]);
        __syncthreads();
        const int ksl = tid >> 6, col = tid & 63;
        float a0 = 0.f, a1 = 0.f, a2 = 0.f, a3 = 0.f;
        const float* w = p.w_ada + (size_t)l * D * 3072 + (size_t)(ksl * 128) * 3072 + c0 + col;
#pragma unroll 32
        for (int kk = 0; kk < 128; ++kk) { const float wv = w[(size_t)kk * 3072]; const int k = ksl * 128 + kk;
            a0 += cact[k] * wv; a1 += cact[1024 + k] * wv; a2 += cact[2048 + k] * wv; a3 += cact[3072 + k] * wv; }
        red[(ksl * 4 + 0) * 64 + col] = a0; red[(ksl * 4 + 1) * 64 + col] = a1; red[(ksl * 4 + 2) * 64 + col] = a2; red[(ksl * 4 + 3) * 64 + col] = a3;
        __syncthreads();
        if (tid < 256) { const int b = tid >> 6; float s = p.b_ada[l * 3072 + c0 + col];
#pragma unroll
            for (int q = 0; q < 8; ++q) s += red[(q * 4 + b) * 64 + col];
            ada[(l * 4 + b) * 3072 + c0 + col] = s; }
        __syncthreads();
    }
    __syncthreads();
    LAS float* scr = (LAS float*)(lds + wave * 8704);
    const int gw = bid * 8 + wave, NGW = G * 8;
    constexpr int I_IN = 16 * 288, I_OUT = 32 * 32, I_L = I_IN + I_OUT;
    for (int it = gw; it < 2 * I_L; it += NGW) {
        const int l = it / I_L; int r = it % I_L;
        if (r < I_IN) { const int kb = r / 288, nb = r % 288; const int n0 = nb * 32, tl_ = n0 >> 8, cl_ = n0 & 255;
            const int cs = (tl_ >= 12 && tl_ < 20) ? ((cl_ < 128) ? 3072 + 128 * (tl_ - 12) + cl_ : 4096 + 128 * (tl_ - 12) + cl_ - 128) : (n0 < 5120 ? n0 : n0 + 8);
            p0_transpose_item(p.w_in + (size_t)l * D * NSRC, NSRC, cs, D, (bf16_t*)(p.ws + WS_WIN) + (size_t)l * NPC * D, n0, kb * 64, scr, lane); }
        else { r -= I_IN; const int kb = r / 32, nb = r % 32;
            p0_transpose_item(p.w_out + (size_t)l * 2048 * D, D, nb * 32, 2048, (bf16_t*)(p.ws + WS_WOUT) + (size_t)l * D * 2048, nb * 32, kb * 64, scr, lane); }
    }
}

DI void phase_norm(const Params& p, int l, const float* xin, LAS unsigned char* lds, int G, int bid) {
    int tid = threadIdx.x; asm volatile("" : "+v"(tid));
    const int lane = tid & 63, wave = tid >> 6;
    const int gw = bid * 8 + wave, NGW = G * 8;
    const float* ada = (const float*)(p.ws + WS_ADA) + (size_t)l * 4 * 3072;
    const float* ng = p.norm_g + l * D;
    const float* wg = (const float*)(p.ws + WS_WG) + (size_t)l * D * 8;
    bf16_t* H = (bf16_t*)(p.ws + WS_H);
    float* gates = (float*)(p.ws + WS_GATES);
    LAS float* pa = (LAS float*)lds; LAS float* pb = (LAS float*)(lds + 16384);
    for (int i = tid; i < 4096; i += NT) { const int b_ = i >> 10, k_ = i & 1023; pa[i] = ng[k_] * (1.0f + ada[b_ * 3072 + 1024 + k_]); pb[i] = ada[b_ * 3072 + k_]; }
    __syncthreads();
    f32x4 w0[4][4], w1[4][4];
#pragma unroll
    for (int j = 0; j < 4; ++j)
#pragma unroll
        for (int e = 0; e < 4; ++e) { const int k = 256 * j + 4 * lane + e; w0[j][e] = *(const f32x4*)(wg + (size_t)k * 8); w1[j][e] = *(const f32x4*)(wg + (size_t)k * 8 + 4); }
    f32x4 vn[4];
    if (gw < M) {
#pragma unroll
        for (int j = 0; j < 4; ++j) vn[j] = ((const f32x4*)(xin + (size_t)gw * D) + lane)[64 * j]; }
    for (int row = gw; row < M; row += NGW) {
        const int b = row / S;
        f32x4 v[4]; float ss = 0.f;
#pragma unroll
        for (int j = 0; j < 4; ++j) v[j] = vn[j];
        if (row + NGW < M) {
#pragma unroll
            for (int j = 0; j < 4; ++j) vn[j] = ((const f32x4*)(xin + (size_t)(row + NGW) * D) + lane)[64 * j]; }
#pragma unroll
        for (int j = 0; j < 4; ++j) ss += (v[j].x * v[j].x + v[j].y * v[j].y) + (v[j].z * v[j].z + v[j].w * v[j].w);
        const float rstd = 1.0f / sqrtf(wave_sum(ss) * (1.f / D) + EPS);
        f32x4 g0 = {0.f, 0.f, 0.f, 0.f}, g1 = {0.f, 0.f, 0.f, 0.f};
        unsigned long long* o8 = (unsigned long long*)(H + (size_t)row * D) + lane;
#pragma unroll
        for (int j = 0; j < 4; ++j) {
            const int k = 256 * j + 4 * lane;
            const f32x4 aa = *(const LAS f32x4*)(pa + b * 1024 + k), sh = *(const LAS f32x4*)(pb + b * 1024 + k);
            const f32x4 h = (v[j] * rstd) * aa + sh;
#pragma unroll
            for (int e = 0; e < 4; ++e) { g0 += w0[j][e] * h[e]; g1 += w1[j][e] * h[e]; }
            o8[64 * j] = (unsigned long long)cvt_pk_bf16(h.x, h.y) | ((unsigned long long)cvt_pk_bf16(h.z, h.w) << 32);
        }
#pragma unroll
        for (int e = 0; e < 4; ++e) { g0[e] = wave_sum(g0[e]); g1[e] = wave_sum(g1[e]); }
        if (lane == 0) { *(f32x4*)(gates + (size_t)row * 8) = g0; *(f32x4*)(gates + (size_t)row * 8 + 4) = g1; }
    }
}

DI void tables_stage2(const Params& p, int seg, LAS float* mtab, int bid);
DI void phase_prep(const Params& p, int l, int seg, LAS unsigned char* lds, int G, int bid) {
    LAS float* mtab = (LAS float*)lds;
    tables_stage2(p, seg, mtab, bid);
    int tid = threadIdx.x; asm volatile("" : "+v"(tid));
    const int lane = tid & 63, wave = tid >> 6;
    const bf16_t* P = (const bf16_t*)(p.ws + WS_P);
    bf16_t* QK = (bf16_t*)(p.ws + WS_QK);
    bf16_t* halo = (bf16_t*)(p.ws + WS_HALO);
    const float* cw = p.conv_w + (size_t)l * 4 * 2048; const float* cb = p.conv_b + (size_t)l * 2048;
    for (int it = bid * NT + tid; it < (MSEG / 32) * 256; it += G * NT) {
        const int rb = it >> 8, cgp = it & 255, c0 = cgp * 8;
        const int lrow0 = rb * 32, b = lrow0 / SEG, tt0 = lrow0 % SEG;
        float w[4][8], bias[8];
#pragma unroll
        for (int i = 0; i < 4; ++i) { const f32x4 a = *(const f32x4*)(cw + i * 2048 + c0), c = *(const f32x4*)(cw + i * 2048 + c0 + 4);
#pragma unroll
            for (int e = 0; e < 4; ++e) { w[i][e] = a[e]; w[i][4 + e] = c[e]; } }
        { const f32x4 a = *(const f32x4*)(cb + c0), c = *(const f32x4*)(cb + c0 + 4);
#pragma unroll
            for (int e = 0; e < 4; ++e) { bias[e] = a[e]; bias[4 + e] = c[e]; } }
        const float osc = (c0 >= 1024) ? 0.0625f : 1.f;
        const float* t1p = (const float*)(p.ws + WS_GTAB) + ((c0 & 1023) >> 8) * 4;
        const bool isk = (c0 >= 1024);
        const float mch = mtab[(b * 4 + ((c0 & 1023) >> 8)) * 64 + (tt0 >> 6)];
        u32x4 hraw[3];
#pragma unroll
        for (int i = 0; i < 3; ++i) {
            if (tt0 > 0) hraw[i] = *(const u32x4*)(P + (size_t)(lrow0 - 3 + i) * NPC + c0);
            else if (seg > 0) hraw[i] = *(const u32x4*)(halo + ((size_t)(((seg - 1) & 1) * 4 + b) * 3 + i) * 2048 + c0);
            else hraw[i] = (u32x4){0u, 0u, 0u, 0u};
        }
        float h[3][8];
#pragma unroll
        for (int i = 0; i < 3; ++i)
#pragma unroll
            for (int q = 0; q < 4; ++q) { h[i][2 * q] = bflo(hraw[i][q]); h[i][2 * q + 1] = bfhi(hraw[i][q]); }
        const bool save = (tt0 + 32 == SEG);
        u32x4 rawA[8]; float tA[8];
#pragma unroll
        for (int j = 0; j < 8; ++j) { rawA[j] = *(const u32x4*)(P + (size_t)(lrow0 + j) * NPC + c0); tA[j] = t1p[(size_t)(lrow0 + j) * 16 + (isk ? 1 : 0)]; }
#pragma unroll
        for (int rr = 0; rr < 4; ++rr) {
            u32x4 rawB[8]; float tB[8];
            if (rr < 3) {
#pragma unroll
                for (int j = 0; j < 8; ++j) { rawB[j] = *(const u32x4*)(P + (size_t)(lrow0 + 8 * (rr + 1) + j) * NPC + c0); tB[j] = t1p[(size_t)(lrow0 + 8 * (rr + 1) + j) * 16 + (isk ? 1 : 0)]; }
            }
#pragma unroll
            for (int j = 0; j < 8; ++j) {
                const int r = 8 * rr + j;
                const u32x4 raw = rawA[j];
                float cur[8], o[8];
                const float rsc = osc * (isk ? tA[j] : __expf(-fmaxf(mch, tA[j])));
#pragma unroll
                for (int q = 0; q < 4; ++q) { cur[2 * q] = bflo(raw[q]); cur[2 * q + 1] = bfhi(raw[q]); }
#pragma unroll
                for (int e = 0; e < 8; ++e) { const float y = w[0][e] * h[0][e] + w[1][e] * h[1][e] + w[2][e] * h[2][e] + w[3][e] * cur[e] + bias[e];
                    o[e] = siluf_(y) * rsc; h[0][e] = h[1][e]; h[1][e] = h[2][e]; h[2][e] = cur[e]; }
                u32x4 ov; ov.x = cvt_pk_bf16(o[0], o[1]); ov.y = cvt_pk_bf16(o[2], o[3]); ov.z = cvt_pk_bf16(o[4], o[5]); ov.w = cvt_pk_bf16(o[6], o[7]);
                *(u32x4*)(QK + (size_t)(lrow0 + r) * 2048 + c0) = ov;
                if (save && r >= 29) *(u32x4*)(halo + ((size_t)((seg & 1) * 4 + b) * 3 + (r - 29)) * 2048 + c0) = raw;
            }
            if (rr < 3) {
#pragma unroll
                for (int j = 0; j < 8; ++j) { rawA[j] = rawB[j]; tA[j] = tB[j]; }
            }
        }
    }
}

DI void phase_tables(const Params& p, int l, int seg, int G, int bid) {
    int tid = threadIdx.x; asm volatile("" : "+v"(tid));
    const int lane = tid & 63, wave = tid >> 6;
    const float* gates = (const float*)(p.ws + WS_GATES);
    f32x4* t1 = (f32x4*)(p.ws + WS_GTAB);
    float* t2raw = (float*)(p.ws + WS_T2RAW);
    for (int it = wave * G + bid; it < NB * 4 * NCH; it += 8 * G) {
        const int b = it / (4 * NCH), hh = (it / NCH) & 3, ch = it % NCH;
        const int lrow = b * SEG + ch * 64 + lane, grow = b * S + seg * SEG + ch * 64 + lane;
        const float li = gates[(size_t)grow * 8 + hh] + p.b_ig[l * 4 + hh];
        const float fp = gates[(size_t)grow * 8 + 4 + hh] + p.b_fg[l * 4 + hh];
        const float lf = fminf(fp, 0.f) - log1pf(expf(-fabsf(fp)));
        float bc = lf;
#pragma unroll
        for (int d = 1; d < 64; d <<= 1) { const float t = __shfl_up(bc, d); if (lane >= d) bc += t; }
        const float u = li - bc; float cm = u;
#pragma unroll
        for (int d = 1; d < 64; d <<= 1) { const float t = __shfl_up(cm, d); if (lane >= d) cm = fmaxf(cm, t); }
        t1[(size_t)lrow * 4 + hh] = (f32x4){cm, expf(u), bc, 0.f};
        if (lane == 63) { t2raw[((size_t)(b * NCH + ch) * 4 + hh) * 2] = bc; t2raw[((size_t)(b * NCH + ch) * 4 + hh) * 2 + 1] = cm; }
    }
}
DI void tables_stage2(const Params& p, int seg, LAS float* mtab, int bid) {
    int tid = threadIdx.x; asm volatile("" : "+v"(tid));
    const int lane = tid & 63, wave = tid >> 6;
    const float* t2raw = (const float*)(p.ws + WS_T2RAW);
    f32x4* t2 = (f32x4*)(p.ws + WS_T2);
    float* msave = (float*)(p.ws + WS_MSAVE);
    const bool narrow = (gridDim.x == 256);
    const int t_lo = narrow ? 4 * (bid >> 6) + wave : wave, t_hi = narrow ? (wave < 4 ? t_lo + 1 : 0) : NB * 4;
    const bool pub = narrow ? ((bid & 63) == 0) : (bid == 0);
    for (int t = t_lo; t < t_hi; t += 8) {
        const int b = t >> 2, hh = t & 3;
        const float bL = t2raw[((size_t)(b * NCH + lane) * 4 + hh) * 2], cmL = t2raw[((size_t)(b * NCH + lane) * 4 + hh) * 2 + 1];
        float m = (seg == 0) ? 0.f : msave[seg * 16 + t];
        float mmine = 0.f;
        for (int c = 0; c < NCH; ++c) { const float bl = __builtin_bit_cast(float, __builtin_amdgcn_readlane(__builtin_bit_cast(int, bL), c)), cl = __builtin_bit_cast(float, __builtin_amdgcn_readlane(__builtin_bit_cast(int, cmL), c)); if (lane == c) mmine = m; m = bl + fmaxf(m, cl); }
        mtab[t * 64 + lane] = mmine;
        if (pub) { const float mnew = bL + fmaxf(mmine, cmL);
            t2[(size_t)(b * NCH + lane) * 4 + hh] = (f32x4){expf(bL), expf(bL - mnew), expf(bL + mmine - mnew), mmine};
            if (lane == 0) msave[(seg + 1) * 16 + t] = m; }
    }
    __syncthreads();
}

#define MX_BAR() do { asm volatile("s_waitcnt lgkmcnt(0)" ::: "memory"); __builtin_amdgcn_s_barrier(); asm volatile("" ::: "memory"); } while (0)
constexpr int QP = 528;

constexpr int PS_QI = 0, PS_KI = 64 * QP, PS_VI = 2 * 64 * QP, PS_PI = 3 * 64 * QP, PS_PP = 144, PS_END = PS_PI + 64 * PS_PP;
static_assert(PS_END <= LDS_BYTES - 64, "PS LDS map");
DI void phase_ps(const Params& p, int seg, LAS unsigned char* lds, int G, int bid) {
    int tid = threadIdx.x; asm volatile("" : "+v"(tid));
    const int lane = tid & 63, wave = __builtin_amdgcn_readfirstlane(tid >> 6);
    const int li = wave & 3, ks = wave >> 2;
    bf16_t* P = (bf16_t*)(p.ws + WS_P);
    const bf16_t* QK = (const bf16_t*)(p.ws + WS_QK);
    float* dnb = (float*)(p.ws + WS_DN2);
    const unsigned ldsb = (unsigned)(size_t)lds;
    constexpr int NITEM = 32 * NCH;
    u32x4 pq[4], pk[4], pv[4];
#define PS_LOAD(item_) do { const int st_ = (item_) / NCH, ch_ = (item_) % NCH; const int grp_ = st_ >> 4, b_ = (st_ >> 2) & 3, hh_ = st_ & 3; \
        const bf16_t *qb_, *kb_, *vb_; int qp_; \
        if (grp_ == 0) { qb_ = QK + hh_ * 256; kb_ = QK + 1024 + hh_ * 256; qp_ = 2048; vb_ = P + 2048 + hh_ * 256; } \
        else { qb_ = P + 5120 + hh_ * 256; kb_ = P + 6144 + hh_ * 256; qp_ = NPC; vb_ = P + 7168 + hh_ * 256; } \
        const int r0_ = b_ * SEG + ch_ * 64; int tl_ = tid; asm volatile("" : "+v"(tl_)); \
        _Pragma("unroll") for (int i = 0; i < 4; ++i) { const int idx = tl_ + 512 * i, row = idx >> 5, c16 = idx & 31; \
            pq[i] = *(const u32x4*)(qb_ + (size_t)(r0_ + row) * qp_ + c16 * 8); pk[i] = *(const u32x4*)(kb_ + (size_t)(r0_ + row) * qp_ + c16 * 8); \
            pv[i] = *(const u32x4*)(vb_ + (size_t)(r0_ + row) * NPC + c16 * 8); } } while (0)
    int item = bid;
    if (item < NITEM) PS_LOAD(item);
    for (; item < NITEM; item += G) {
        const int stream = item / NCH, ch = item % NCH;
        const int grp = stream >> 4, b = (stream >> 2) & 3, hh = stream & 3;
        const int lrow0 = b * SEG + ch * 64;
        bf16_t* cellb = P + grp * 1024 + hh * 256;
        { int ts_ = tid; asm volatile("" : "+v"(ts_));
#pragma unroll
          for (int i = 0; i < 4; ++i) { const int idx = ts_ + 512 * i, row = idx >> 5, c16 = idx & 31;
              *(LAS u32x4*)(lds + PS_QI + row * QP + c16 * 16) = pq[i]; *(LAS u32x4*)(lds + PS_KI + row * QP + c16 * 16) = pk[i]; *(LAS u32x4*)(lds + PS_VI + row * QP + c16 * 16) = pv[i]; } }
        if (item + G < NITEM) PS_LOAD(item + G);
        MX_BAR();
        { int ln = lane; asm volatile("" : "+v"(ln)); const int i16 = ln & 15, g4 = ln >> 4; const int lq = 16 * li + i16;
          f32x4 sa0 = {0.f, 0.f, 0.f, 0.f}, sa1 = {0.f, 0.f, 0.f, 0.f};
          if (2 * ks <= li) {
              bf16x8 qf[8], ka[8], kb[8];
#pragma unroll
              for (int kk = 0; kk < 8; ++kk) { qf[kk] = *(const LAS bf16x8*)(lds + PS_QI + lq * QP + 64 * kk + 16 * g4);
                  ka[kk] = *(const LAS bf16x8*)(lds + PS_KI + (32 * ks + i16) * QP + 64 * kk + 16 * g4);
                  kb[kk] = *(const LAS bf16x8*)(lds + PS_KI + (32 * ks + 16 + i16) * QP + 64 * kk + 16 * g4); }
              __builtin_amdgcn_sched_barrier(0);
#pragma unroll
              for (int kk = 0; kk < 8; ++kk) { sa0 = __builtin_amdgcn_mfma_f32_16x16x32_bf16(ka[kk], qf[kk], sa0, 0, 0, 0);
                  sa1 = __builtin_amdgcn_mfma_f32_16x16x32_bf16(kb[kk], qf[kk], sa1, 0, 0, 0); }
          }
          float pw[8];
#pragma unroll
          for (int r = 0; r < 4; ++r) { const int s0 = 32 * ks + 4 * g4 + r; pw[r] = (s0 <= lq) ? sa0[r] : 0.f; pw[4 + r] = (s0 + 16 <= lq) ? sa1[r] : 0.f; }
          u32x2 w0, w1; w0.x = cvt_pk_bf16(pw[0], pw[1]); w0.y = cvt_pk_bf16(pw[2], pw[3]); w1.x = cvt_pk_bf16(pw[4], pw[5]); w1.y = cvt_pk_bf16(pw[6], pw[7]);
          *(LAS u32x2*)(lds + PS_PI + lq * PS_PP + (32 * ks + 4 * g4) * 2) = w0;
          *(LAS u32x2*)(lds + PS_PI + lq * PS_PP + (32 * ks + 16 + 4 * g4) * 2) = w1; }
        MX_BAR();
        { int ln = lane; asm volatile("" : "+v"(ln)); const int i16 = ln & 15, g4 = ln >> 4;
          s16x4 t[8];
          const unsigned va = ldsb + PS_VI + (8 * g4 + (i16 >> 2)) * QP + (2 * wave) * 32 + 8 * (ln & 3);
          asm volatile("ds_read_b64_tr_b16 %0, %8\n\tds_read_b64_tr_b16 %1, %8 offset:2112\n\tds_read_b64_tr_b16 %2, %8 offset:16896\n\tds_read_b64_tr_b16 %3, %8 offset:19008\n\t"
                       "ds_read_b64_tr_b16 %4, %8 offset:32\n\tds_read_b64_tr_b16 %5, %8 offset:2144\n\tds_read_b64_tr_b16 %6, %8 offset:16928\n\tds_read_b64_tr_b16 %7, %8 offset:19040\n\ts_waitcnt lgkmcnt(0)"
                       : "=&v"(t[0]), "=&v"(t[1]), "=&v"(t[2]), "=&v"(t[3]), "=&v"(t[4]), "=&v"(t[5]), "=&v"(t[6]), "=&v"(t[7]) : "v"(va) : "memory");
          bf16x8 pf[4][2];
#pragma unroll
          for (int lt = 0; lt < 4; ++lt)
#pragma unroll
              for (int kk = 0; kk < 2; ++kk) pf[lt][kk] = *(const LAS bf16x8*)(lds + PS_PI + (16 * lt + i16) * PS_PP + 64 * kk + 16 * g4);
          __builtin_amdgcn_sched_barrier(0);
#pragma unroll
          for (int a = 0; a < 2; ++a) {
              const bf16x8 v0 = __builtin_shufflevector(t[4 * a], t[4 * a + 1], 0, 1, 2, 3, 4, 5, 6, 7), v1 = __builtin_shufflevector(t[4 * a + 2], t[4 * a + 3], 0, 1, 2, 3, 4, 5, 6, 7);
#pragma unroll
              for (int lt = 0; lt < 4; ++lt) {
                  f32x4 o = __builtin_amdgcn_mfma_f32_16x16x32_bf16(v0, pf[lt][0], (f32x4){0.f, 0.f, 0.f, 0.f}, 0, 0, 0);
                  o = __builtin_amdgcn_mfma_f32_16x16x32_bf16(v1, pf[lt][1], o, 0, 0, 0);
                  u32x2 w; w.x = cvt_pk_bf16(o[0], o[1]); w.y = cvt_pk_bf16(o[2], o[3]);
                  *(u32x2*)(cellb + (size_t)(lrow0 + 16 * lt + i16) * NPC + 16 * (2 * wave + a) + 4 * g4) = w;
              }
          }
          if (grp == 0 && wave == 0) { float sum = 0.f;
#pragma unroll
              for (int c = 0; c < 8; ++c) { const u32x4 pr = *(const LAS u32x4*)(lds + PS_PI + ln * PS_PP + 16 * c);
#pragma unroll
                  for (int q = 0; q < 4; ++q) sum += bflo(pr[q]) + bfhi(pr[q]); }
              dnb[(size_t)(lrow0 + ln) * 4 + hh] = sum; }
        }
        MX_BAR();
    }
#undef PS_LOAD
}

constexpr int VP2 = 112;
constexpr int L_QI = 0, L_KI = 64 * QP, L_CI = 2 * 64 * QP, L_VI = L_CI + 48 * QP, L_RED = L_VI + 64 * VP2, L_MXEND = L_RED + 4 * 12 * 64 * 4;
static_assert(L_MXEND <= LDS_BYTES - 64, "mixer LDS map");
DI void phase_mixer(const Params& p, int seg, LAS unsigned char* lds, int G, int bid) {
    int tid = threadIdx.x; asm volatile("" : "+v"(tid));
    const int lane = tid & 63, wave = __builtin_amdgcn_readfirstlane(tid >> 6);
    const int li = wave & 3, ks = wave >> 2;
    bf16_t* P = (bf16_t*)(p.ws + WS_P);
    const bf16_t* QK = (const bf16_t*)(p.ws + WS_QK);
    const f32x4* t1 = (const f32x4*)(p.ws + WS_GTAB);
    const f32x4* t2 = (const f32x4*)(p.ws + WS_T2);
    float* dnb = (float*)(p.ws + WS_DN);
    const float* dn2 = (const float*)(p.ws + WS_DN2);
    float* csave = (float*)(p.ws + WS_CSAVE);
    const unsigned ldsb = (unsigned)(size_t)lds;

    for (int item = bid; item < 256; item += G) {
        const int stream = (item >> 5) * 4 + (item & 3), vs = (item & 31) >> 2;
        const int grp = stream >> 4, b = (stream >> 2) & 3, hh = stream & 3;
        const bool stab = (grp == 0);
        constexpr int nvt = 3;
        const bf16_t *qb, *kb, *vb; int qpitch;
        if (grp == 0) { qb = QK + hh * 256; kb = QK + 1024 + hh * 256; qpitch = 2048; vb = P + 2048 + hh * 256 + vs * 32; }
        else { qb = P + 5120 + hh * 256; kb = P + 6144 + hh * 256; qpitch = NPC; vb = P + 7168 + hh * 256 + vs * 32; }
        bf16_t* cellb = P + grp * 1024 + hh * 256 + vs * 32;
        const int lrowb = b * SEG;
        const float gdec = exp2f(64.0f * log2f(1.0f - exp2f(-5.0f - (float)hh)));
#define MX_G(ch_) (stab ? ((const float*)(t2 + (size_t)(b * NCH + (ch_)) * 4 + hh))[0] : gdec)
#define MX_MCH(ch_) (((const float*)(t2 + (size_t)(b * NCH + (ch_)) * 4 + hh))[3])

        f32x4 C[2][3];
        if (seg == 0) {
#pragma unroll
            for (int a = 0; a < 2; ++a)
#pragma unroll
                for (int v = 0; v < 3; ++v) C[a][v] = (f32x4){0.f, 0.f, 0.f, 0.f};
        } else {
#pragma unroll
            for (int a = 0; a < 2; ++a)
#pragma unroll
                for (int v = 0; v < 3; ++v) C[a][v] = *(const f32x4*)(csave + ((size_t)item * 6 + a * 3 + v) * 2048 + tid * 4);
        }
        for (int i = tid; i < 64 * 8; i += NT) { const int r = i >> 3, c2 = i & 7; *(LAS unsigned*)(lds + L_VI + r * VP2 + 64 + c2 * 4) = (c2 == 0) ? 0x00003F80u : 0u; }
#define MX_WRITE_CIMG(em_) do { int lnC = lane; const int i16 = lnC & 15, g4 = lnC >> 4; const float e_ = (em_); _Pragma("unroll") for (int a = 0; a < 2; ++a) _Pragma("unroll") for (int v = 0; v < 3; ++v) { if (v < nvt) { \
            u32x2 w; (void)e_; w.x = cvt_pk_bf16(C[a][v][0], C[a][v][1]); w.y = cvt_pk_bf16(C[a][v][2], C[a][v][3]); \
            *(LAS u32x2*)(lds + L_CI + (16 * v + i16) * QP + (16 * (2 * wave + a) + 4 * g4) * 2) = w; } } } while (0)
        float g_c = MX_G(0);
        MX_WRITE_CIMG(1.0f);

        u32x4 pq[4], pk[4], pv; u32x2 pin[2]; float pden = 0.f, pcm = 0.f, pbc = 0.f, pmch = 0.f;
        const unsigned voq = (unsigned)(((tid >> 5) * qpitch + (tid & 31) * 8) * 2);
        const unsigned vov = (unsigned)(((tid >> 2) * NPC + (tid & 3) * 8) * 2);
        const unsigned vop = (unsigned)(((16 * ((tid >> 6) & 3) + (tid & 15)) * NPC + 4 * ((tid & 63) >> 4)) * 2);
        const size_t qstep16 = (size_t)16 * qpitch * 2;
#define MX_LOADQ(ch) do { const int r0_ = lrowb + (ch) * 64; const char* qr_ = (const char*)(qb + (size_t)r0_ * qpitch); \
            _Pragma("unroll") for (int i = 0; i < 4; ++i) pq[i] = *(const u32x4*)(qr_ + i * qstep16 + voq); \
            if (tid < 256) { const char* cr_ = (const char*)(cellb + (size_t)r0_ * NPC); \
                pin[0] = *(const u32x2*)(cr_ + vop); pin[1] = *(const u32x2*)(cr_ + 32 + vop); \
                if (stab && vs == 0 && ((tid & 63) >> 4) == 0) { const int lr_ = r0_ + 16 * ((tid >> 6) & 3) + (tid & 15); pden = dn2[(size_t)lr_ * 4 + hh]; const float* tk_ = (const float*)(t1 + (size_t)lr_ * 4 + hh); pcm = tk_[0]; pbc = tk_[2]; pmch = MX_MCH(ch); } } } while (0)
#define MX_LOADK(ch) do { const int r0_ = lrowb + (ch) * 64; const char* kr_ = (const char*)(kb + (size_t)r0_ * qpitch); \
            _Pragma("unroll") for (int i = 0; i < 4; ++i) pk[i] = *(const u32x4*)(kr_ + i * qstep16 + voq); \
            if (tid < 256) pv = *(const u32x4*)((const char*)(vb + (size_t)r0_ * NPC) + vov); } while (0)
#define MX_STAGEQ() do { int ts_ = tid; \
            _Pragma("unroll") for (int i = 0; i < 4; ++i) { const int idx = ts_ + 512 * i, row = idx >> 5, c16 = idx & 31; \
                *(LAS u32x4*)(lds + L_QI + row * QP + c16 * 16) = pq[i]; } } while (0)
#define MX_STAGEK(cs_) do { int ts_ = tid; const float c_ = (cs_); \
            _Pragma("unroll") for (int i = 0; i < 4; ++i) { const int idx = ts_ + 512 * i, row = idx >> 5, c16 = idx & 31; \
                *(LAS u32x4*)(lds + L_KI + row * QP + c16 * 16) = pk[i]; } \
            if (ts_ < 256) { const int s_ = ts_ >> 2, c4_ = ts_ & 3; (void)c_; \
                *(LAS u32x4*)(lds + L_VI + s_ * VP2 + c4_ * 16) = pv; } } while (0)

        u32x2 cin[2]; float cden = 0.f, cemr = 1.f;
        MX_LOADQ(0);
        MX_LOADK(0);
        MX_STAGEQ();
        cin[0] = pin[0]; cin[1] = pin[1]; cden = pden; cemr = __expf(-(pbc + fmaxf(pmch, pcm)));
        MX_BAR();
        for (int ch = 0; ch < NCH; ++ch) {
            float g_n = 1.f;
            if (ch + 1 < NCH) { g_n = MX_G(ch + 1); MX_LOADQ(ch + 1); }
            int lnA = lane;
            const int i16 = lnA & 15, g4 = lnA >> 4;
            const int lq = 16 * li + i16;
            bf16x8 qf[4], cf[3][4];
#pragma unroll
            for (int k4 = 0; k4 < 4; ++k4) qf[k4] = *(const LAS bf16x8*)(lds + L_QI + lq * QP + 64 * (4 * ks + k4) + 16 * g4);
#pragma unroll
            for (int v = 0; v < 3; ++v)
#pragma unroll
                for (int k4 = 0; k4 < 4; ++k4) cf[v][k4] = *(const LAS bf16x8*)(lds + L_CI + (16 * v + i16) * QP + 64 * (4 * ks + k4) + 16 * g4);
            __builtin_amdgcn_sched_barrier(0);
            f32x4 num[3];
#pragma unroll
            for (int v = 0; v < 3; ++v) num[v] = (f32x4){0.f, 0.f, 0.f, 0.f};
            if (ks == 0) { num[0] = (f32x4){bflo(cin[0].x), bfhi(cin[0].x), bflo(cin[0].y), bfhi(cin[0].y)};
                num[1] = (f32x4){bflo(cin[1].x), bfhi(cin[1].x), bflo(cin[1].y), bfhi(cin[1].y)}; num[2][0] = cden; }
#pragma unroll
            for (int k4 = 0; k4 < 4; ++k4)
#pragma unroll
                for (int v = 0; v < 3; ++v) if (v < nvt) num[v] = __builtin_amdgcn_mfma_f32_16x16x32_bf16(cf[v][k4], qf[k4], num[v], 0, 0, 0);
            if (ks == 1) {
#pragma unroll
                for (int v = 0; v < 3; ++v)
#pragma unroll
                    for (int r = 0; r < 4; ++r) *(LAS float*)(lds + L_RED + ((li * 12 + v * 4 + r) * 64 + lnA) * 4) = num[v][r];
            }
            MX_STAGEK(1.0f);
            if (ch + 1 < NCH) MX_LOADK(ch + 1);
            MX_BAR();
            if (ks == 0) {
#pragma unroll
                for (int v = 0; v < 3; ++v)
#pragma unroll
                    for (int r = 0; r < 4; ++r) num[v][r] += *(const LAS float*)(lds + L_RED + ((li * 12 + v * 4 + r) * 64 + lnA) * 4);
                const int lrow = lrowb + ch * 64 + lq;
#pragma unroll
                for (int v = 0; v < 2; ++v) { u32x2 w; w.x = cvt_pk_bf16(num[v][0], num[v][1]); w.y = cvt_pk_bf16(num[v][2], num[v][3]);
                    *(u32x2*)(cellb + (size_t)lrow * NPC + 16 * v + 4 * g4) = w; }
                if (stab && vs == 0 && g4 == 0) dnb[(size_t)lrow * 4 + hh] = fmaxf(fabsf(num[2][0]), cemr);
            }
            {
                s16x4 t0[4], t1r[4], tv[12];
                int lnB = lane;
                const int j16 = lnB & 15, h4 = lnB >> 4;
                const unsigned addr0 = ldsb + L_KI + (8 * h4 + (j16 >> 2)) * QP + (2 * wave) * 32 + 8 * (lnB & 3);
                const unsigned addrv = ldsb + L_VI + (8 * h4 + (j16 >> 2)) * VP2 + 8 * (lnB & 3);
                asm volatile("ds_read_b64_tr_b16 %0, %8\n\tds_read_b64_tr_b16 %1, %8 offset:2112\n\tds_read_b64_tr_b16 %2, %8 offset:16896\n\tds_read_b64_tr_b16 %3, %8 offset:19008\n\t"
                             "ds_read_b64_tr_b16 %4, %8 offset:32\n\tds_read_b64_tr_b16 %5, %8 offset:2144\n\tds_read_b64_tr_b16 %6, %8 offset:16928\n\tds_read_b64_tr_b16 %7, %8 offset:19040\n\ts_waitcnt lgkmcnt(0)"
                             : "=&v"(t0[0]), "=&v"(t0[1]), "=&v"(t0[2]), "=&v"(t0[3]), "=&v"(t1r[0]), "=&v"(t1r[1]), "=&v"(t1r[2]), "=&v"(t1r[3]) : "v"(addr0) : "memory");
                asm volatile("ds_read_b64_tr_b16 %0, %12\n\tds_read_b64_tr_b16 %1, %12 offset:448\n\tds_read_b64_tr_b16 %2, %12 offset:3584\n\tds_read_b64_tr_b16 %3, %12 offset:4032\n\t"
                             "ds_read_b64_tr_b16 %4, %12 offset:32\n\tds_read_b64_tr_b16 %5, %12 offset:480\n\tds_read_b64_tr_b16 %6, %12 offset:3616\n\tds_read_b64_tr_b16 %7, %12 offset:4064\n\t"
                             "ds_read_b64_tr_b16 %8, %12 offset:64\n\tds_read_b64_tr_b16 %9, %12 offset:512\n\tds_read_b64_tr_b16 %10, %12 offset:3648\n\tds_read_b64_tr_b16 %11, %12 offset:4096\n\ts_waitcnt lgkmcnt(0)"
                             : "=&v"(tv[0]), "=&v"(tv[1]), "=&v"(tv[2]), "=&v"(tv[3]), "=&v"(tv[4]), "=&v"(tv[5]), "=&v"(tv[6]), "=&v"(tv[7]), "=&v"(tv[8]), "=&v"(tv[9]), "=&v"(tv[10]), "=&v"(tv[11]) : "v"(addrv) : "memory");
                __builtin_amdgcn_sched_barrier(0);
#pragma unroll
                for (int v = 0; v < 3; ++v) if (v < nvt) {
                    const bf16x8 vb0 = __builtin_shufflevector(tv[4 * v], tv[4 * v + 1], 0, 1, 2, 3, 4, 5, 6, 7);
                    C[0][v] = __builtin_amdgcn_mfma_f32_16x16x32_bf16(__builtin_shufflevector(t0[0], t0[1], 0, 1, 2, 3, 4, 5, 6, 7), vb0, C[0][v], 0, 0, 0);
                    C[1][v] = __builtin_amdgcn_mfma_f32_16x16x32_bf16(__builtin_shufflevector(t1r[0], t1r[1], 0, 1, 2, 3, 4, 5, 6, 7), vb0, C[1][v], 0, 0, 0); }
#pragma unroll
                for (int v = 0; v < 3; ++v) if (v < nvt) {
                    const bf16x8 vb1 = __builtin_shufflevector(tv[4 * v + 2], tv[4 * v + 3], 0, 1, 2, 3, 4, 5, 6, 7);
                    C[0][v] = __builtin_amdgcn_mfma_f32_16x16x32_bf16(__builtin_shufflevector(t0[2], t0[3], 0, 1, 2, 3, 4, 5, 6, 7), vb1, C[0][v], 0, 0, 0);
                    C[1][v] = __builtin_amdgcn_mfma_f32_16x16x32_bf16(__builtin_shufflevector(t1r[2], t1r[3], 0, 1, 2, 3, 4, 5, 6, 7), vb1, C[1][v], 0, 0, 0); }
            }
#pragma unroll
            for (int a = 0; a < 2; ++a)
#pragma unroll
                for (int v = 0; v < 3; ++v) C[a][v] = C[a][v] * g_c;
            MX_WRITE_CIMG(1.0f);
            if (ch + 1 < NCH) { MX_STAGEQ(); cin[0] = pin[0]; cin[1] = pin[1]; cden = pden; cemr = __expf(-(pbc + fmaxf(pmch, pcm))); }
            MX_BAR();
            g_c = g_n;
        }
        if (seg + 1 < NSEG) {
#pragma unroll
            for (int a = 0; a < 2; ++a)
#pragma unroll
                for (int v = 0; v < 3; ++v) *(f32x4*)(csave + ((size_t)item * 6 + a * 3 + v) * 2048 + tid * 4) = C[a][v];
        }
        __syncthreads();
#undef MX_WRITE_CIMG
#undef MX_LOADQ
#undef MX_LOADK
#undef MX_STAGEQ
#undef MX_STAGEK
#undef MX_G
#undef MX_MCH
    }
}

DI void phase_post(const Params& p, int l, int G, int bid) {
    int tid = threadIdx.x; asm volatile("" : "+v"(tid));
    const int lane = tid & 63, wave = tid >> 6;
    bf16_t* P = (bf16_t*)(p.ws + WS_P);
    const float* dnb = (const float*)(p.ws + WS_DN);
    const int hh = lane >> 4;
    f32x4 gnm[4], gnr[4];
#pragma unroll
    for (int q = 0; q < 4; ++q) { gnm[q] = *(const f32x4*)(p.gn_m + l * 1024 + 16 * lane + 4 * q); gnr[q] = *(const f32x4*)(p.gn_r + l * 1024 + 16 * lane + 4 * q); }
    u32x4 nc0, nc1, nz0, nz1, no0 = {0u, 0u, 0u, 0u}, no1 = {0u, 0u, 0u, 0u}; float ndn = 1.f;
#define PP_LOAD(it_) do { const int lr_ = (it_) >> 1, gp_ = (it_) & 1; const bf16_t* rp_ = P + (size_t)lr_ * NPC + 16 * lane; \
        nc0 = *(const u32x4*)(rp_ + gp_ * 1024); nc1 = *(const u32x4*)(rp_ + gp_ * 1024 + 8); \
        nz0 = *(const u32x4*)(rp_ + (gp_ == 0 ? 3072 : 8192)); nz1 = *(const u32x4*)(rp_ + (gp_ == 0 ? 3072 : 8192) + 8); \
        if (gp_ == 0) ndn = dnb[(size_t)lr_ * 4 + hh]; } while (0)
    if (bid * 8 + wave < MSEG * 2) PP_LOAD(bid * 8 + wave);
    for (int it = bid * 8 + wave; it < MSEG * 2; it += G * 8) {
        const int lrow = it >> 1, grp = it & 1;
        bf16_t* cp = P + (size_t)lrow * NPC + grp * 1024 + 16 * lane;
        const u32x4 c0 = nc0, c1 = nc1, z0 = nz0, z1 = nz1, o0 = no0, o1 = no1;
        const float inv = (grp == 0) ? 1.0f / ndn : 1.f;
        if (it + G * 8 < MSEG * 2) PP_LOAD(it + G * 8);
        float h[16], sum = 0.f;
#pragma unroll
        for (int q = 0; q < 4; ++q) { h[2 * q] = bflo(c0[q]) * inv; h[2 * q + 1] = bfhi(c0[q]) * inv; h[8 + 2 * q] = bflo(c1[q]) * inv; h[8 + 2 * q + 1] = bfhi(c1[q]) * inv; }
#pragma unroll
        for (int e = 0; e < 16; ++e) sum += h[e];
#pragma unroll
        for (int o = 1; o < 16; o <<= 1) sum += __shfl_xor(sum, o);
        const float mu = sum * (1.f / 256.f);
        float q2 = 0.f;
#pragma unroll
        for (int e = 0; e < 16; ++e) { h[e] -= mu; q2 += h[e] * h[e]; }
#pragma unroll
        for (int o = 1; o < 16; o <<= 1) q2 += __shfl_xor(q2, o);
        const float rstd = 1.0f / sqrtf(q2 * (1.f / 256.f) + EPS);
        float y[16];
#pragma unroll
        for (int q = 0; q < 4; ++q) {
            const f32x4 gn = (grp == 0) ? gnm[q] : gnr[q];
            const unsigned zz0 = (q < 2) ? z0[2 * q] : z1[2 * q - 4], zz1 = (q < 2) ? z0[2 * q + 1] : z1[2 * q - 3];
            const unsigned oo0 = (q < 2) ? o0[2 * q] : o1[2 * q - 4], oo1 = (q < 2) ? o0[2 * q + 1] : o1[2 * q - 3];
            const float zv[4] = {bflo(zz0), bfhi(zz0), bflo(zz1), bfhi(zz1)};
            const float ov[4] = {bflo(oo0), bfhi(oo0), bflo(oo1), bfhi(oo1)};
#pragma unroll
            for (int e = 0; e < 4; ++e) y[4 * q + e] = (h[4 * q + e] * rstd * gn[e]) * zv[e];
        }
        u32x4 w0, w1;
        w0.x = cvt_pk_bf16(y[0], y[1]); w0.y = cvt_pk_bf16(y[2], y[3]); w0.z = cvt_pk_bf16(y[4], y[5]); w0.w = cvt_pk_bf16(y[6], y[7]);
        w1.x = cvt_pk_bf16(y[8], y[9]); w1.y = cvt_pk_bf16(y[10], y[11]); w1.z = cvt_pk_bf16(y[12], y[13]); w1.w = cvt_pk_bf16(y[14], y[15]);
        *(u32x4*)cp = w0; *(u32x4*)(cp + 8) = w1;
    }
#undef PP_LOAD
}

DI void phase_final(const Params& p, int G, int bid) {
    int tid = threadIdx.x; asm volatile("" : "+v"(tid));
    const int lane = tid & 63, wave = tid >> 6;
    f32x4 vn[4];
    if (bid * 8 + wave < M) {
#pragma unroll
        for (int j = 0; j < 4; ++j) vn[j] = ((const f32x4*)(p.out + (size_t)(bid * 8 + wave) * D) + lane)[64 * j]; }
    f32x4 fg[4];
#pragma unroll
    for (int j = 0; j < 4; ++j) fg[j] = *(const f32x4*)(p.final_g + 256 * j + 4 * lane);
    for (int row = bid * 8 + wave; row < M; row += G * 8) {
        f32x4* xr = (f32x4*)(p.out + (size_t)row * D) + lane;
        f32x4 v[4]; float ss = 0.f;
#pragma unroll
        for (int j = 0; j < 4; ++j) v[j] = vn[j];
        if (row + G * 8 < M) {
#pragma unroll
            for (int j = 0; j < 4; ++j) vn[j] = ((const f32x4*)(p.out + (size_t)(row + G * 8) * D) + lane)[64 * j]; }
#pragma unroll
        for (int j = 0; j < 4; ++j) ss += (v[j].x * v[j].x + v[j].y * v[j].y) + (v[j].z * v[j].z + v[j].w * v[j].w);
        const float rstd = 1.0f / sqrtf(wave_sum(ss) * (1.f / D) + EPS);
#pragma unroll
        for (int j = 0; j < 4; ++j) xr[64 * j] = (v[j] * rstd) * fg[j];
    }
}

constexpr size_t WS_BAR = 0;
#define XB_TMO      128
#define XB_XCNT(j)  (256  + 64 * (j))
#define XB_XSUB(j)  (1280 + 64 * (j))
#define XB_XGEN(j)  (2304 + 64 * (j))
#define XB_TOP      3328
#define XB_TOPGEN   3392
#define XCD_BAR_WORDS 3456
#define XB_SPIN_CAP (1u << 22)
DI unsigned xb_ld(unsigned* p)              { return __hip_atomic_load(p, __ATOMIC_RELAXED, __HIP_MEMORY_SCOPE_AGENT); }
DI unsigned xb_add(unsigned* p, unsigned v) { return __hip_atomic_fetch_add(p, v, __ATOMIC_RELAXED, __HIP_MEMORY_SCOPE_AGENT); }
DI unsigned xb_xcc_id() { return (unsigned)__builtin_amdgcn_s_getreg((3 << 11) | 20) & 0xFu; }
#define XB_SPIN(cond, bar) do { unsigned _sp = 0; while (cond) { __builtin_amdgcn_s_sleep(1); \
    if ((++_sp & 255u) == 0u) { if (xb_ld(&(bar)[XB_TMO])) break; if (_sp > XB_SPIN_CAP) { atomicAdd(&(bar)[XB_TMO], 1u); break; } } } } while (0)
struct XcdBarrier { unsigned* bar; unsigned x; volatile LAS unsigned* st; };
DI XcdBarrier xcd_barrier_post(unsigned* bar, volatile LAS unsigned* st) {
    XcdBarrier b; b.bar = bar; b.x = xb_xcc_id(); b.st = st;
    if (threadIdx.x == 0) (void)xb_add(&bar[XB_XCNT(b.x)], 1u);
    return b;
}
DI void xcd_barrier_complete(unsigned* bar, unsigned x, unsigned& nloc, unsigned& nx) {
    const unsigned G = gridDim.x * gridDim.y * gridDim.z;
    unsigned sum, cnt, mine, sp = 0u;
    for (;;) {
        sum = 0u; cnt = 0u; mine = 0u;
#pragma unroll
        for (unsigned j = 0; j < 16; ++j) { const unsigned c = xb_ld(&bar[XB_XCNT(j)]); sum += c; cnt += (c > 0u) ? 1u : 0u; mine = (j == x) ? c : mine; }
        if (sum == G) break;
        __builtin_amdgcn_s_sleep(1);
        if ((++sp & 255u) == 0u) { if (xb_ld(&bar[XB_TMO])) break; if (sp > XB_SPIN_CAP) { atomicAdd(&bar[XB_TMO], 1u); break; } }
    }
    nloc = mine > 0u ? mine : 1u; nx = cnt > 0u ? cnt : 1u;
}
DI void xcd_barrier(const XcdBarrier& b) {
    asm volatile("s_waitcnt vmcnt(0)" ::: "memory");
    __syncthreads();
    if (threadIdx.x == 0) {
        unsigned* bar = b.bar;
        __builtin_amdgcn_s_waitcnt(0);
        unsigned nloc = b.st[0], nx = b.st[1];
        if (nloc == 0u) { xcd_barrier_complete(bar, b.x, nloc, nx); b.st[0] = nloc; b.st[1] = nx; }
        const unsigned old = xb_add(&bar[XB_XSUB(b.x)], 1u);
        const unsigned gen = old / nloc;
        if (old + 1u == (gen + 1u) * nloc) {
            __builtin_amdgcn_fence(__ATOMIC_RELEASE, "agent");
            asm volatile("s_waitcnt vmcnt(0)" ::: "memory");
            const unsigned og = xb_add(&bar[XB_TOP], 1u);
            const unsigned tg = og / nx;
            if (og + 1u == (tg + 1u) * nx) xb_add(&bar[XB_TOPGEN], 1u);
            else XB_SPIN(xb_ld(&bar[XB_TOPGEN]) == tg, bar);
            __builtin_amdgcn_fence(__ATOMIC_ACQUIRE, "agent");
            xb_add(&bar[XB_XGEN(b.x)], 1u);
            asm volatile("s_waitcnt vmcnt(0)" ::: "memory");
        } else {
            XB_SPIN(xb_ld(&bar[XB_XGEN(b.x)]) == gen, bar);
            __builtin_amdgcn_fence(__ATOMIC_ACQUIRE, "agent");
            asm volatile("s_waitcnt vmcnt(0)" ::: "memory");
        }
    }
    __syncthreads();
}

static_assert(NCH == 64, "tables_stage2 maps chunks to lanes");
constexpr int N_PHASES = 28;
constexpr int REP_P0 = 1, REP_PN = 1, REP_G1 = 1, REP_PE = 1, REP_MX = 1;
__global__ void __launch_bounds__(NT, 2) fwd_megakernel(Params p) {
    extern __shared__ __attribute__((aligned(16))) unsigned char lds_raw[];
    LAS unsigned char* lds = (LAS unsigned char*)lds_raw;
    cg::grid_group grid = cg::this_grid();
    const int G = gridDim.x, bid = blockIdx.x;
    const int lo = p.ph_lo;
    const bool fuse_pf = (G == 256) && (p.ph_lo == 0) && (p.ph_hi == N_PHASES);
    const int hi = fuse_pf ? p.ph_hi - 1 : p.ph_hi;
    int ph = 0, nsync = 0;
    volatile LAS unsigned* xst = (volatile LAS unsigned*)(lds + LDS_BYTES - 16);
    if (threadIdx.x < 4) xst[threadIdx.x] = 0u;
    __syncthreads();
    XcdBarrier xbar = xcd_barrier_post((unsigned*)(p.ws + WS_BAR), xst);
    unsigned* slotw = (unsigned*)(p.ws + WS_BAR) + XCD_BAR_WORDS;
    if (threadIdx.x == 0) { const unsigned xc = xb_xcc_id() & 7u; xst[2] = xc; xst[3] = xb_add(&slotw[64 * xc], 1u); }
#define GSYNC() do { if (lo < 0) grid.sync(); else xcd_barrier(xbar); ++nsync; } while (0)
#define RUNR(rep, ...) do { if (ph >= lo && ph < hi) { for (int r_ = 0; r_ < (rep); ++r_) { __VA_ARGS__; if (r_ + 1 < (rep) || ph + 1 < hi) GSYNC(); } } ++ph; } while (0)
#define RUN(...) RUNR(1, __VA_ARGS__)
    RUNR(REP_P0, phase0(p, lds, G, bid));
    int vb = bid, vc = bid;
    if (G == 256 && lo == 0 && hi > 1) {
        bool ok = true;
        for (int j = 0; j < 8; ++j) ok = ok && (xb_ld(&slotw[64 * j]) == 32u);
        if (ok) { const int xc = (int)xst[2], sl = (int)xst[3]; vb = xc * 32 + sl; vc = sl * 8 + xc; }
    }
    vb = __builtin_amdgcn_readfirstlane(vb); vc = __builtin_amdgcn_readfirstlane(vc);
    for (int l = 0; l < 2; ++l) {
        const float* xin = (l == 0) ? p.x : p.out;
        RUNR(REP_PN, phase_norm(p, l, xin, lds, G, bid));
        for (int seg = 0; seg < NSEG; ++seg) {
            RUNR(REP_G1, { phase_tables(p, l, seg, G, bid); pg8::Gemm g{(const bf16_t*)(p.ws + WS_H), (const bf16_t*)(p.ws + WS_WIN) + (size_t)l * NPC * D, D, D, MSEG / 256, NPC / 256, seg, 0};
                  pg8::EpiP E{(bf16_t*)(p.ws + WS_P), p.pos, (const float*)(p.ws + WS_INVF), seg};
                  pg8::gemm_phase(lds, g, G, vc, E); });
            RUNR(REP_PE, phase_prep(p, l, seg, lds, G, bid));
            RUN(phase_ps(p, seg, lds, G, bid));
            RUNR(REP_MX, phase_mixer(p, seg, lds, G, vb));
            RUN(phase_post(p, l, G, bid));
            RUN({ pg8::Gemm g{(const bf16_t*)(p.ws + WS_P), (const bf16_t*)(p.ws + WS_WOUT) + (size_t)l * D * 2048, NPC, 2048, MSEG / 256, D / 256, seg, 1};
                  if (fuse_pf && l == 1) {
                      pg8::EpiResNorm E{xin, p.out, (const float*)(p.ws + WS_ADA) + (size_t)l * 4 * 3072 + 2048, seg, p.final_g, (float*)(p.ws + WS_XCH), (unsigned*)(p.ws + WS_XCNT)};
                      pg8::gemm_phase(lds, g, G, vc, E);
                  } else {
                      pg8::EpiRes E{xin, p.out, (const float*)(p.ws + WS_ADA) + (size_t)l * 4 * 3072 + 2048, seg};
                      pg8::gemm_phase(lds, g, G, vc, E);
                  } });
        }
    }
    RUN(phase_final(p, G, bid));
#undef RUN
#undef RUNR
#undef GSYNC
}

#ifndef MK_SPLIT
#define MK_SPLIT 0
#endif
extern "C" void kernel_launch(void* const* d_in, const int* in_sizes, int n_in, void* d_out, int out_size, void* d_ws, size_t ws_size, hipStream_t stream) {
    static int grid = 0;
    if (grid == 0) {
        int dev = 0, cus = 0, per_cu = 0;
        (void)hipGetDevice(&dev);
        (void)hipDeviceGetAttribute(&cus, hipDeviceAttributeMultiprocessorCount, dev);
        (void)hipFuncSetAttribute((const void*)fwd_megakernel, hipFuncAttributeMaxDynamicSharedMemorySize, LDS_BYTES);
        (void)hipOccupancyMaxActiveBlocksPerMultiprocessor(&per_cu, (const void*)fwd_megakernel, NT, LDS_BYTES);
        if (per_cu < 1) per_cu = 1;
        grid = cus * 1;
        if (ws_size < WS_END) { fprintf(stderr, "kernel_launch: workspace too small (%zu < %zu)\n", ws_size, (size_t)WS_END); grid = -1; }
    }
    if (grid < 0) return;
    Params p{};
    p.x = (const float*)d_in[0]; p.c = (const float*)d_in[1]; p.pos = (const int*)d_in[2]; p.w_ada = (const float*)d_in[3]; p.b_ada = (const float*)d_in[4];
    p.norm_g = (const float*)d_in[5]; p.w_in = (const float*)d_in[6]; p.conv_w = (const float*)d_in[7]; p.conv_b = (const float*)d_in[8];
    p.b_ig = (const float*)d_in[9]; p.b_fg = (const float*)d_in[10]; p.gn_m = (const float*)d_in[11]; p.gn_r = (const float*)d_in[12];
    p.w_out = (const float*)d_in[13]; p.final_g = (const float*)d_in[14];
    p.out = (float*)d_out; p.ws = (unsigned char*)d_ws;
#if MK_SPLIT
    for (int ph = 0; ph < N_PHASES; ++ph) { p.ph_lo = ph; p.ph_hi = ph + 1; hipLaunchKernelGGL(fwd_megakernel, dim3(grid), dim3(NT), LDS_BYTES, stream, p); }
#else
    p.ph_lo = 0; p.ph_hi = N_PHASES;
    (void)hipMemsetAsync((char*)d_ws + WS_BAR, 0, 32768, stream);
    void* args[] = {&p};
    hipError_t e = hipLaunchCooperativeKernel((const void*)fwd_megakernel, dim3(grid), dim3(NT), args, LDS_BYTES, stream);
    if (e != hipSuccess) fprintf(stderr, "cooperative launch failed: %s (grid %d)\n", hipGetErrorString(e), grid);
#endif
}
```
